# Optimizing an MI355X kernel written in HIP

```python
import math
import jax, jax.numpy as jnp
from jax import lax
import numpy as np

D_MODEL = 1024
BATCH = 8
SEQ = 2048
DEPTH = 2

CHUNK = 64
Q_BLOCK = 128
EPS = 1e-6
N_HEADS = 8
QK_NOPE = 64
QK_ROPE = 32
QK_HEAD = QK_NOPE + QK_ROPE
V_HEAD = 64
Q_LORA = 256
KV_LORA = 128
ROPE_THETA = 10000.0
ATTN_WIDTH = N_HEADS * V_HEAD
SSM_WIDTH = 256
SSM_GROUP = 16
SSM_GROUPS = SSM_WIDTH // SSM_GROUP
SSM_STATE = 64
DT_MIN = 1e-3
DT_MAX = 1e-1
CONV_WIDTH = 256
CONV_K = 31
MIX_WIDTH = ATTN_WIDTH + SSM_WIDTH + CONV_WIDTH
IN_SIZES = [Q_LORA, KV_LORA, QK_ROPE, SSM_WIDTH, CONV_WIDTH, CONV_WIDTH]
IN_PROJ = sum(IN_SIZES)
IN_SPLITS = [int(v) for v in np.cumsum(IN_SIZES)[:-1]]
N_EGROUPS = 4
EXP_PER_GROUP = 8
N_EXPERTS = N_EGROUPS * EXP_PER_GROUP
TOP_K = 2
D_FF_E = 512
MOE_BLOCK = 128

kernel_name = "hybrid_mla_s5_conformer_hmoe"


def rms_norm(x, w, eps=EPS):
    xf = x.astype(jnp.float32)
    y = xf * lax.rsqrt(jnp.mean(xf * xf, -1, keepdims=True) + eps)
    return (y * w.astype(jnp.float32)).astype(x.dtype)


def layer_norm(x, w, b, eps=1e-5):
    xf = x.astype(jnp.float32)
    mu = jnp.mean(xf, -1, keepdims=True)
    var = jnp.mean(jnp.square(xf - mu), -1, keepdims=True)
    y = (xf - mu) * lax.rsqrt(var + eps) * w.astype(jnp.float32) + b.astype(jnp.float32)
    return y.astype(x.dtype)


def rotary(x, cos, sin):
    x1, x2 = jnp.split(x, 2, axis=-1)
    return jnp.concatenate([x1 * cos - x2 * sin, x1 * sin + x2 * cos], axis=-1)


def mla_mixer(c_q, c_kv, k_pe, cos, sin, q_a_norm, w_uq, kv_a_norm, w_ukv, q_norm, k_norm):
    B, L, _ = c_q.shape
    q = (rms_norm(c_q, q_a_norm) @ w_uq).reshape(B, L, N_HEADS, QK_HEAD)
    kv = (rms_norm(c_kv, kv_a_norm) @ w_ukv).reshape(B, L, N_HEADS, QK_NOPE + V_HEAD)
    k_nope, v = kv[..., :QK_NOPE], kv[..., QK_NOPE:]
    k = jnp.concatenate([k_nope, jnp.broadcast_to(k_pe[:, :, None, :], (B, L, N_HEADS, QK_ROPE))], -1)
    q = rms_norm(q, q_norm)
    k = rms_norm(k, k_norm)
    cos = cos.astype(q.dtype)
    sin = sin.astype(q.dtype)
    q = jnp.concatenate([q[..., :QK_NOPE], rotary(q[..., QK_NOPE:], cos, sin)], -1)
    k = jnp.concatenate([k[..., :QK_NOPE], rotary(k[..., QK_NOPE:], cos, sin)], -1)
    q = q.transpose(0, 2, 1, 3)
    k = k.transpose(0, 2, 1, 3)
    v = v.transpose(0, 2, 1, 3)
    scale = QK_HEAD ** -0.5
    chunk_id = jnp.arange(L) // CHUNK
    neg = jnp.finfo(jnp.float32).min
    outs = []
    for i in range(L // Q_BLOCK):
        q0 = i * Q_BLOCK
        kv_len = q0 + Q_BLOCK
        s = jnp.einsum('bhqd,bhkd->bhqk', q[:, :, q0:kv_len], k[:, :, :kv_len]).astype(jnp.float32) * scale
        mask = chunk_id[None, :kv_len] <= chunk_id[q0:kv_len, None]
        s = jnp.where(mask, s, neg)
        p = jax.nn.softmax(s, axis=-1).astype(v.dtype)
        outs.append(jnp.einsum('bhqk,bhkd->bqhd', p, v[:, :, :kv_len]))
    o = jnp.concatenate(outs, axis=1)
    return o.reshape(B, L, ATTN_WIDTH)


def s5_mixer(u, lam_re, lam_im, b_re, b_im, c_re, c_im, d_skip, log_dt, w_glu):
    B, L, _ = u.shape
    f32 = jnp.float32
    lam = lax.complex(lam_re.astype(f32), lam_im.astype(f32))
    dt = jnp.exp(log_dt.astype(f32))[:, None]
    lam_bar = jnp.exp(lam * dt)
    b_mat = lax.complex(b_re.astype(f32), b_im.astype(f32))
    b_bar = ((lam_bar - 1.0) / lam)[..., None] * b_mat
    c_mat = lax.complex(c_re.astype(f32), c_im.astype(f32))
    ug = u.astype(f32).reshape(B, L, SSM_GROUPS, SSM_GROUP)
    bu = jnp.einsum('blgc,gpc->blgp', ug.astype(jnp.complex64), b_bar)
    a = jnp.broadcast_to(lam_bar, bu.shape)

    def combine(e1, e2):
        a1, b1 = e1
        a2, b2 = e2
        return a1 * a2, a2 * b1 + b2

    _, xs = lax.associative_scan(combine, (a, bu), axis=1)
    y = jnp.einsum('blgp,gcp->blgc', xs, c_mat).real + d_skip.astype(f32) * ug
    y = y.reshape(B, L, SSM_WIDTH)
    z = jax.nn.gelu(y)
    out = z * jax.nn.sigmoid(z @ w_glu.astype(f32))
    return out.astype(u.dtype)


def conv_mixer(a, g, dw_w, dw_b, ln_w, ln_b):
    u = a * jax.nn.sigmoid(g)
    u = jnp.pad(u, ((0, 0), (CONV_K - 1, 0), (0, 0)))
    y = lax.conv_general_dilated(u, dw_w[:, None, :].astype(u.dtype), window_strides=(1,),
                                 padding='VALID', dimension_numbers=('NWC', 'WIO', 'NWC'),
                                 feature_group_count=CONV_WIDTH)
    y = layer_norm(y + dw_b.astype(y.dtype), ln_w, ln_b)
    return jax.nn.silu(y)


def grouped_experts(xf, expert_id, gates, w1, w3, w2):
    N, D = xf.shape
    A = N * TOP_K
    flat_e = expert_id.reshape(A)
    flat_tok = jnp.repeat(jnp.arange(N, dtype=jnp.int32), TOP_K)
    flat_gate = gates.reshape(A)
    order = jnp.argsort(flat_e)
    e_sorted = flat_e[order]
    counts = jnp.bincount(flat_e, length=N_EXPERTS)
    padded = (counts + MOE_BLOCK - 1) // MOE_BLOCK * MOE_BLOCK
    pad_end = jnp.cumsum(padded)
    pad_start = pad_end - padded
    start = jnp.cumsum(counts) - counts
    dest = pad_start[e_sorted] + jnp.arange(A, dtype=jnp.int32) - start[e_sorted]
    n_rows = (A + MOE_BLOCK - 1) // MOE_BLOCK * MOE_BLOCK + N_EXPERTS * MOE_BLOCK
    n_blocks = n_rows // MOE_BLOCK
    row_tok = jnp.full((n_rows,), N, jnp.int32).at[dest].set(flat_tok[order])
    row_gate = jnp.zeros((n_rows,), flat_gate.dtype).at[dest].set(flat_gate[order])
    block_e = jnp.minimum(jnp.searchsorted(pad_end, jnp.arange(n_blocks, dtype=pad_end.dtype) * MOE_BLOCK,
                                           side='right'), N_EXPERTS - 1)
    x_pad = jnp.concatenate([xf, jnp.zeros((1, D), xf.dtype)], axis=0)
    x_rows = x_pad[row_tok].reshape(n_blocks, MOE_BLOCK, D)

    def expert_block(args):
        xb, e = args
        hb = jax.nn.silu(xb @ w1[e]) * (xb @ w3[e])
        return hb @ w2[e]

    y_rows = lax.map(expert_block, (x_rows, block_e)).reshape(n_rows, D)
    y_rows = y_rows * row_gate[:, None].astype(y_rows.dtype)
    return jax.ops.segment_sum(y_rows, row_tok, num_segments=N + 1)[:N]


def hier_moe(h, w_grp, b_grp, w_exp, b_exp, w1, w3, w2):
    B, L, D = h.shape
    xf = h.reshape(B * L, D)
    N = xf.shape[0]
    rows = jnp.arange(N)
    grp_logits = (xf @ w_grp).astype(jnp.float32) + b_grp.astype(jnp.float32)
    p_grp = jax.nn.softmax(grp_logits, axis=-1)
    g_sel = jnp.argmax(grp_logits, axis=-1)
    exp_logits = ((xf @ w_exp).astype(jnp.float32) + b_exp.astype(jnp.float32)).reshape(N, N_EGROUPS, EXP_PER_GROUP)
    p_in = jax.nn.softmax(exp_logits[rows, g_sel], axis=-1)
    top_p, top_i = lax.top_k(p_in, TOP_K)
    top_p = top_p / jnp.sum(top_p, axis=-1, keepdims=True)
    gates = p_grp[rows, g_sel][:, None] * top_p
    expert_id = (g_sel[:, None] * EXP_PER_GROUP + top_i).astype(jnp.int32)
    y = grouped_experts(xf, expert_id, gates, w1, w3, w2)
    return y.reshape(B, L, D)


def setup_inputs(seed: int = 0) -> dict:
    key = jax.random.key(seed)
    ks = iter(jax.random.split(key, 40))
    f32 = jnp.float32

    def nrm(shape, scale):
        return jax.random.normal(next(ks), shape, f32) * scale

    def gain(shape):
        return 1.0 + 0.01 * jax.random.normal(next(ks), shape, f32)

    Lr = DEPTH
    x = jax.random.normal(next(ks), (BATCH, SEQ, D_MODEL), f32)
    offsets = jax.random.randint(next(ks), (BATCH, 1), 0, 8192, jnp.int32)
    positions = offsets + jnp.arange(SEQ, dtype=jnp.int32)[None, :]
    n_idx = jnp.arange(SSM_STATE, dtype=f32)
    lam_re = -0.5 + 0.01 * jax.random.normal(next(ks), (Lr, SSM_GROUPS, SSM_STATE), f32)
    lam_im = math.pi * n_idx + 0.01 * jax.random.normal(next(ks), (Lr, SSM_GROUPS, SSM_STATE), f32)
    log_dt = jax.random.uniform(next(ks), (Lr, SSM_GROUPS), f32, math.log(DT_MIN), math.log(DT_MAX))
    return {
        "x": x,
        "positions": positions,
        "mix_norm": gain((Lr, D_MODEL)),
        "w_in": nrm((Lr, D_MODEL, IN_PROJ), D_MODEL ** -0.5),
        "q_a_norm": gain((Lr, Q_LORA)),
        "w_uq": nrm((Lr, Q_LORA, N_HEADS * QK_HEAD), Q_LORA ** -0.5),
        "kv_a_norm": gain((Lr, KV_LORA)),
        "w_ukv": nrm((Lr, KV_LORA, N_HEADS * (QK_NOPE + V_HEAD)), KV_LORA ** -0.5),
        "q_norm": gain((Lr, QK_HEAD)),
        "k_norm": gain((Lr, QK_HEAD)),
        "ssm_lam_re": lam_re,
        "ssm_lam_im": lam_im,
        "ssm_b_re": nrm((Lr, SSM_GROUPS, SSM_STATE, SSM_GROUP), (2 * SSM_GROUP) ** -0.5),
        "ssm_b_im": nrm((Lr, SSM_GROUPS, SSM_STATE, SSM_GROUP), (2 * SSM_GROUP) ** -0.5),
        "ssm_c_re": nrm((Lr, SSM_GROUPS, SSM_GROUP, SSM_STATE), (2 * SSM_STATE) ** -0.5),
        "ssm_c_im": nrm((Lr, SSM_GROUPS, SSM_GROUP, SSM_STATE), (2 * SSM_STATE) ** -0.5),
        "ssm_d": nrm((Lr, SSM_GROUPS, SSM_GROUP), 0.5),
        "ssm_log_dt": log_dt,
        "ssm_w_glu": nrm((Lr, SSM_WIDTH, SSM_WIDTH), SSM_WIDTH ** -0.5),
        "conv_dw_w": nrm((Lr, CONV_K, CONV_WIDTH), CONV_K ** -0.5),
        "conv_dw_b": nrm((Lr, CONV_WIDTH), 0.01),
        "conv_ln_w": gain((Lr, CONV_WIDTH)),
        "conv_ln_b": nrm((Lr, CONV_WIDTH), 0.01),
        "out_norm": gain((Lr, MIX_WIDTH)),
        "w_out": nrm((Lr, MIX_WIDTH, D_MODEL), MIX_WIDTH ** -0.5),
        "ffn_norm": gain((Lr, D_MODEL)),
        "w_grp": nrm((Lr, D_MODEL, N_EGROUPS), D_MODEL ** -0.5),
        "b_grp": nrm((Lr, N_EGROUPS), 0.01),
        "w_exp": nrm((Lr, D_MODEL, N_EXPERTS), D_MODEL ** -0.5),
        "b_exp": nrm((Lr, N_EXPERTS), 0.01),
        "w1": nrm((Lr, N_EXPERTS, D_MODEL, D_FF_E), D_MODEL ** -0.5),
        "w3": nrm((Lr, N_EXPERTS, D_MODEL, D_FF_E), D_MODEL ** -0.5),
        "w2": nrm((Lr, N_EXPERTS, D_FF_E, D_MODEL), D_FF_E ** -0.5),
    }


def reference(x, positions, mix_norm, w_in, q_a_norm, w_uq, kv_a_norm, w_ukv, q_norm, k_norm,
              ssm_lam_re, ssm_lam_im, ssm_b_re, ssm_b_im, ssm_c_re, ssm_c_im, ssm_d, ssm_log_dt, ssm_w_glu,
              conv_dw_w, conv_dw_b, conv_ln_w, conv_ln_b, out_norm, w_out,
              ffn_norm, w_grp, b_grp, w_exp, b_exp, w1, w3, w2):
    inv_freq = ROPE_THETA ** (-jnp.arange(0, QK_ROPE, 2, dtype=jnp.float32) / QK_ROPE)
    ang = positions.astype(jnp.float32)[..., None] * inv_freq
    cos = jnp.cos(ang)[:, :, None, :]
    sin = jnp.sin(ang)[:, :, None, :]
    for l in range(DEPTH):
        h = rms_norm(x, mix_norm[l])
        proj = h @ w_in[l]
        c_q, c_kv, k_pe, u_ssm, conv_a, conv_g = jnp.split(proj, IN_SPLITS, axis=-1)
        y_attn = mla_mixer(c_q, c_kv, k_pe, cos, sin, q_a_norm[l], w_uq[l], kv_a_norm[l], w_ukv[l],
                           q_norm[l], k_norm[l])
        y_ssm = s5_mixer(u_ssm, ssm_lam_re[l], ssm_lam_im[l], ssm_b_re[l], ssm_b_im[l], ssm_c_re[l],
                         ssm_c_im[l], ssm_d[l], ssm_log_dt[l], ssm_w_glu[l])
        y_conv = conv_mixer(conv_a, conv_g, conv_dw_w[l], conv_dw_b[l], conv_ln_w[l], conv_ln_b[l])
        g = out_norm[l]
        y = jnp.concatenate([
            rms_norm(y_attn, g[:ATTN_WIDTH]),
            rms_norm(y_ssm, g[ATTN_WIDTH:ATTN_WIDTH + SSM_WIDTH]),
            rms_norm(y_conv, g[ATTN_WIDTH + SSM_WIDTH:]),
        ], axis=-1)
        x = x + y @ w_out[l]
        x = x + hier_moe(rms_norm(x, ffn_norm[l]), w_grp[l], b_grp[l], w_exp[l], b_exp[l],
                         w1[l], w3[l], w2[l])
    return x
```

```cpp
#define MK_LAUNCH_PER_PHASE 0
#include <hip/hip_runtime.h>
#include <cstdio>
#include <cstdint>

#define LAS __attribute__((address_space(3)))
#define GAS __attribute__((address_space(1)))
typedef unsigned short bf16;
typedef short bf16x8 __attribute__((ext_vector_type(8)));
typedef short s16x4 __attribute__((ext_vector_type(4)));
typedef float f32x4 __attribute__((ext_vector_type(4)));
typedef float f32x2 __attribute__((ext_vector_type(2)));
typedef float f32x16 __attribute__((ext_vector_type(16)));
typedef unsigned u32x4 __attribute__((ext_vector_type(4)));
typedef unsigned u32x2 __attribute__((ext_vector_type(2)));

constexpr int DM = 1024, NB = 8, SEQ = 2048, NTOK = NB * SEQ, DEPTH = 2;
constexpr int NH = 8, QK_NOPE = 64, QK_ROPE = 32, QKH = 96, VH = 64, QLORA = 256, KVLORA = 128;
constexpr int SSMW = 256, SSG = 16, SSP = 64, CONVW = 256, CONVK = 31, INPROJ = 1184;
constexpr int NEXP = 32, DFF = 512;
constexpr float EPS = 1e-6f;

constexpr size_t MiB = 1u << 20;
constexpr size_t WS_CTL = 0, CTL_ZERO_BYTES = 1 * MiB;
constexpr size_t WS_ROUTER = 1 * MiB;
constexpr size_t WS_COS = 2 * MiB, WS_SIN = 3 * MiB;
constexpr size_t WS_WIN = 4 * MiB;
constexpr size_t WS_WUQ = 9 * MiB;
constexpr size_t WS_WUKV = 10 * MiB;
constexpr size_t WS_WGLU = 11 * MiB;
constexpr size_t WS_WOUT = 12 * MiB;
constexpr size_t WS_SSMTAB = 16 * MiB;
constexpr size_t SSMTAB_LAYER = 9 * MiB, ST_KD = 0, ST_WST = 512 * 1024, ST_VIN = 512 * 1024 + 4 * MiB, ST_LAM = 512 * 1024 + 8 * MiB;
constexpr size_t WS_W13 = 34 * MiB;
constexpr size_t WS_W2 = 162 * MiB;
constexpr size_t WS_XB = 226 * MiB;
constexpr size_t WS_SMALL = 258 * MiB;
constexpr size_t SM_RSTD1 = 0, SM_RSTD2 = 64 * 1024, SM_SSQQ = 128 * 1024  , SM_SSQKV = 384 * 1024  , SM_SSQPE = 640 * 1024  ,
                 SM_SSQO = 704 * 1024  , SM_TOKSLOT = 1216 * 1024  ;
constexpr size_t WS_CQ = 264 * MiB;
constexpr size_t WS_CKV = 272 * MiB;
constexpr size_t WS_USSM = 280 * MiB;
constexpr size_t WS_CONVA = 288 * MiB, WS_CONVG = 296 * MiB;
constexpr size_t WS_Z = 304 * MiB;
constexpr size_t WS_Y = 312 * MiB;
constexpr size_t WS_TOKLIST = 344 * MiB;
constexpr size_t WS_GATELIST = 346 * MiB;
constexpr size_t WS_QRAW = 348 * MiB;
constexpr size_t WS_KVRAW = 380 * MiB;
constexpr size_t WS_Q = 412 * MiB;
constexpr size_t WS_K = 436 * MiB;
constexpr size_t WS_V = 460 * MiB;
constexpr size_t WS_END = 476 * MiB;
constexpr size_t WS_H = 348 * MiB;
constexpr size_t WS_YROWS = 388 * MiB;
constexpr int MAXROWS = 40960;
constexpr int CW_BAR = 4096;
constexpr int CW_CNT = 8192;

constexpr int RING_BYTES = 131072;
constexpr int MISC_OFF = RING_BYTES;
constexpr int MISC_BARW = MISC_OFF;
constexpr int MISC_TAB = MISC_OFF + 64;
constexpr int MISC_RS = MISC_OFF + 1024;
constexpr int LDS_BYTES = 147456;

__device__ __forceinline__ unsigned f2bf(float f) { unsigned u = __builtin_bit_cast(unsigned, f); return (u + 0x7fffu + ((u >> 16) & 1u)) >> 16; }
__device__ __forceinline__ unsigned pk2(float lo, float hi) { return f2bf(lo) | (f2bf(hi) << 16); }
__device__ __forceinline__ float bf2f(unsigned short b) { return __builtin_bit_cast(float, (unsigned)b << 16); }
__device__ __forceinline__ float bflo(unsigned w) { return __builtin_bit_cast(float, w << 16); }
__device__ __forceinline__ float bfhi(unsigned w) { return __builtin_bit_cast(float, w & 0xffff0000u); }
__device__ __forceinline__ float wave_sum(float v) {
#pragma unroll
    for (int o = 1; o < 64; o <<= 1) v += __shfl_xor(v, o);
    return v;
}
__device__ __forceinline__ float sigmoidf_(float x) { return 1.0f / (1.0f + __expf(-x)); }
__device__ __forceinline__ float gelu_tanh(float y) { const float a = 0.7978845608028654f * (y + 0.044715f * y * y * y); const float t = 1.0f - 2.0f / (__expf(2.0f * a) + 1.0f); return 0.5f * y * (1.0f + t); }

namespace pg8 {
constexpr int BM = 256, BK = 64, HALF = 128, HTB = HALF * BK * 2, STAGE_BYTES = 8 * HTB, NXCD = 8, WGM = 8;
__host__ __device__ __forceinline__ int lds_byte(int r, int c) { const int st = (r >> 4) * 2 + (c >> 5), rr = r & 15, cc = c & 31, ob = rr * 64 + cc * 2; return st * 1024 + (ob ^ (((ob >> 9) & 1) << 5)); }
__host__ __device__ __forceinline__ void stage_rc(int b, int& R, int& C) { const int st = b / 1024, sb = b % 1024, swz = sb ^ (((sb >> 9) & 1) << 5); R = (st >> 1) * 16 + swz / 64; C = (st & 1) * 32 + (swz % 64) / 2; }
__host__ __device__ __forceinline__ int perm32(int rho) { const int n = rho >> 4, i = rho & 15; return 8 * (i >> 2) + 4 * n + (i & 3); }

struct Unit { int pm, pn; };
struct Gemm { const bf16* A; const bf16* Bt; int K; };

struct StaticOrder {
    int nM, nN, nwg, G, c;
    __device__ void init(int M, int N, int G_, int c_) { nM = M / BM; nN = N / BM; nwg = nM * nN; G = G_; c = c_; }
    __device__ bool next(int i, Unit& u) const {
        const long L = (long)i * G + c; if (L >= nwg) return false;
        int wgid = (int)L; { const int q = nwg / NXCD, r = nwg % NXCD, xcd = wgid % NXCD, off = wgid / NXCD; wgid = (xcd < r ? xcd * (q + 1) : r * (q + 1) + (xcd - r) * q) + off; }
        const int nig = WGM * nN, gid = wgid / nig, fm = gid * WGM, gsz = (nM - fm) < WGM ? (nM - fm) : WGM;
        u.pm = fm + ((wgid % nig) % gsz); u.pn = (wgid % nig) / gsz; return true;
    }
    __device__ __forceinline__ unsigned arow(const Unit& u, int rloc) const { return (unsigned)(u.pm * BM + rloc); }
};

template <class Epi, class Sched, bool ALIGN_EPI, int KSCALE_T>
__device__ __forceinline__ void gemm_phase(LAS unsigned char* lds, const Gemm g, const Sched& S, const Epi& E, const LAS float* rs, const int tid) {
    const int wid = __builtin_amdgcn_readfirstlane(tid >> 6), lane = tid & 63, wr = wid >> 2, wc = wid & 3, fr = lane & 15, fq = lane >> 4;
    const int K = g.K, nt = K / BK;
    int Rst[2]; unsigned cofs[2]; unsigned voffB[2];
#pragma unroll
    for (int i = 0; i < 2; ++i) { int R, C; stage_rc(tid * 16 + i * 8192, R, C); const int Rb = Epi::PERM ? ((R & ~31) + perm32(R & 31)) : R;
        Rst[i] = R; cofs[i] = (unsigned)C * 2u; voffB[i] = (unsigned)(Rb * K + C) * 2u; }
    const size_t kstep = (size_t)(BK * 2);
    const size_t hstepB = (size_t)HALF * K * 2;
    const size_t tstepB = 2 * hstepB;
    const unsigned ldsw = (unsigned)wid * 1024u;
    const int aoff = lds_byte(wr * 64 + fr, fq * 8), boff = lds_byte(wc * 32 + fr, fq * 8);
#define PG8_SA(b, h) (((b) * 2 + (h)) * HTB)
#define PG8_SB(b, h) ((4 + (b) * 2 + (h)) * HTB)
#define PG8_STAGEB(bufoff, gbase) do { _Pragma("unroll") for (int _i = 0; _i < 2; ++_i) \
        __builtin_amdgcn_global_load_lds((const unsigned*)((const char*)(gbase) + voffB[_i]), (LAS unsigned*)(lds + (bufoff) + ldsw + _i * 8192), 16, 0, 0); } while (0)
#define PG8_STAGEA(bufoff, gbase, vo, h) do { _Pragma("unroll") for (int _i = 0; _i < 2; ++_i) \
        __builtin_amdgcn_global_load_lds((const unsigned*)((const char*)(gbase) + (vo)[h][_i]), (LAS unsigned*)(lds + (bufoff) + ldsw + _i * 8192), 16, 0, 0); } while (0)
#define PG8_LDA(dst, b, h) do { _Pragma("unroll") for (int m = 0; m < 4; ++m) _Pragma("unroll") for (int k = 0; k < 2; ++k) dst[m][k] = *(const LAS bf16x8*)(lds + PG8_SA(b, h) + aoff + m * 2048 + k * 1024); } while (0)
#define PG8_LDB(dst, b, h) do { _Pragma("unroll") for (int n = 0; n < 2; ++n) _Pragma("unroll") for (int k = 0; k < 2; ++k) dst[n][k] = *(const LAS bf16x8*)(lds + PG8_SB(b, h) + boff + n * 2048 + k * 1024); } while (0)
#define PG8_MMA(ai, bj, At, Bt) do { __builtin_amdgcn_s_setprio(1); _Pragma("unroll") for (int m = 0; m < 4; ++m) _Pragma("unroll") for (int n = 0; n < 2; ++n) _Pragma("unroll") for (int k = 0; k < 2; ++k) \
        acc[ai][bj][m][n] = __builtin_amdgcn_mfma_f32_16x16x32_bf16(Bt[n][k], At[m][k], acc[ai][bj][m][n], 0, 0, 0); __builtin_amdgcn_s_setprio(0); } while (0)
#define PG8_WAIT_V(n) asm volatile("s_waitcnt vmcnt(" #n ")" ::: "memory")
#define PG8_WAIT_L(n) asm volatile("s_waitcnt lgkmcnt(" #n ")" ::: "memory")
#define PG8_BAR __builtin_amdgcn_s_barrier()
#define PG8_SCHED __builtin_amdgcn_sched_barrier(0)
#define PG8_AOFFS(vo, u) do { _Pragma("unroll") for (int _h = 0; _h < 2; ++_h) _Pragma("unroll") for (int _i = 0; _i < 2; ++_i) \
        (vo)[_h][_i] = S.arow((u), _h * HALF + Rst[_i]) * (unsigned)(K * 2) + cofs[_i]; } while (0)
    Unit cur, nxt; int ui = 0;
    if (!S.next(0, cur)) return;
    f32x4 acc[2][2][4][2];
#pragma unroll
    for (int a = 0; a < 2; ++a)
#pragma unroll
        for (int b = 0; b < 2; ++b)
#pragma unroll
            for (int m = 0; m < 4; ++m)
#pragma unroll
                for (int n = 0; n < 2; ++n) acc[a][b][m][n] = (f32x4){0.f, 0.f, 0.f, 0.f};
    bf16x8 At[4][2], B0[2][2], B1[2][2];
    unsigned voC[2][2], voN[2][2];
    PG8_AOFFS(voC, cur);
    const char* gA = (const char*)g.A;
    const char* cB = (const char*)g.Bt + (size_t)cur.pn * tstepB;
    PG8_STAGEB(PG8_SB(0, 0), cB); PG8_STAGEB(PG8_SB(0, 1), cB + hstepB); PG8_STAGEA(PG8_SA(0, 0), gA, voC, 0); PG8_STAGEA(PG8_SA(0, 1), gA, voC, 1);
    if (wr == 1) PG8_BAR;
    PG8_WAIT_V(2); PG8_BAR;
    PG8_STAGEB(PG8_SB(1, 0), cB + kstep); PG8_STAGEA(PG8_SA(1, 0), gA + kstep, voC, 0); PG8_STAGEB(PG8_SB(1, 1), cB + hstepB + kstep);
    PG8_WAIT_V(6); PG8_BAR;
    for (;;) {
        const bool has_next = S.next(ui + 1, nxt);
        if (has_next) { PG8_AOFFS(voN, nxt); } else {
#pragma unroll
            for (int _h = 0; _h < 2; ++_h)
#pragma unroll
                for (int _i = 0; _i < 2; ++_i) voN[_h][_i] = voC[_h][_i]; }
        const char* nB = has_next ? (const char*)g.Bt + (size_t)nxt.pn * tstepB : cB;
        for (int t = 0; t < nt; t += 2) {
            const bool last = (t == nt - 2);
            if (KSCALE_T >= 0 && t == KSCALE_T) {
#pragma unroll
                for (int ai = 0; ai < 2; ++ai)
#pragma unroll
                    for (int m = 0; m < 4; ++m) { const float sc = rs[ai * HALF + wr * 64 + m * 16 + fr];
#pragma unroll
                        for (int bj = 0; bj < 2; ++bj)
#pragma unroll
                            for (int n = 0; n < 2; ++n) acc[ai][bj][m][n] *= sc; }
            }
            const char* a1 = gA + (size_t)(t + 1) * kstep;
            const char* a2 = last ? gA : gA + (size_t)(t + 2) * kstep; const char* b2 = last ? nB : cB + (size_t)(t + 2) * kstep;
            const char* a3 = a2 + kstep; const char* b3 = b2 + kstep;
            unsigned vo2[2][2];
#pragma unroll
            for (int _h = 0; _h < 2; ++_h)
#pragma unroll
                for (int _i = 0; _i < 2; ++_i) vo2[_h][_i] = last ? voN[_h][_i] : voC[_h][_i];
            PG8_LDB(B0, 0, 0); PG8_LDB(B1, 0, 1); PG8_SCHED; PG8_LDA(At, 0, 0); PG8_STAGEA(PG8_SA(1, 1), a1, voC, 1);
            PG8_WAIT_V(8); PG8_WAIT_L(0); PG8_BAR; PG8_MMA(0, 0, At, B0); PG8_MMA(0, 1, At, B1); PG8_BAR; PG8_SCHED;
            PG8_LDA(At, 0, 1); PG8_STAGEB(PG8_SB(0, 0), b2); PG8_STAGEB(PG8_SB(0, 1), b2 + hstepB); PG8_STAGEA(PG8_SA(0, 0), a2, vo2, 0);
            PG8_WAIT_V(8); PG8_WAIT_L(0); PG8_BAR; PG8_MMA(1, 0, At, B0); PG8_MMA(1, 1, At, B1); PG8_BAR; PG8_SCHED;
            PG8_LDB(B0, 1, 0); PG8_LDB(B1, 1, 1); PG8_SCHED; PG8_LDA(At, 1, 0); PG8_STAGEA(PG8_SA(0, 1), a2, vo2, 1);
            PG8_WAIT_V(8); PG8_WAIT_L(0); PG8_BAR; PG8_MMA(0, 0, At, B0); PG8_MMA(0, 1, At, B1); PG8_BAR; PG8_SCHED;
            PG8_LDA(At, 1, 1); PG8_STAGEB(PG8_SB(1, 0), b3); PG8_STAGEB(PG8_SB(1, 1), b3 + hstepB); PG8_STAGEA(PG8_SA(1, 0), a3, vo2, 0);
            PG8_WAIT_V(8); PG8_WAIT_L(0); PG8_BAR; PG8_MMA(1, 0, At, B0); PG8_MMA(1, 1, At, B1); PG8_BAR; PG8_SCHED;
        }
        if constexpr (ALIGN_EPI) { if (wr == 0) PG8_BAR; }
        if constexpr (!Epi::AFTER_DRAIN) { E(acc, cur, wr, wc, fr, fq); }
        if (!has_next) break;
#pragma unroll
        for (int a = 0; a < 2; ++a)
#pragma unroll
            for (int b = 0; b < 2; ++b)
#pragma unroll
                for (int m = 0; m < 4; ++m)
#pragma unroll
                    for (int n = 0; n < 2; ++n) acc[a][b][m][n] = (f32x4){0.f, 0.f, 0.f, 0.f};
        cur = nxt; cB = nB; ++ui;
#pragma unroll
        for (int _h = 0; _h < 2; ++_h)
#pragma unroll
            for (int _i = 0; _i < 2; ++_i) voC[_h][_i] = voN[_h][_i];
        if constexpr (ALIGN_EPI) { if (wr == 1) PG8_BAR; }
    }
    PG8_WAIT_V(0);
    if constexpr (!ALIGN_EPI) { if (wr == 0) PG8_BAR; }
    PG8_BAR;
    if constexpr (Epi::AFTER_DRAIN) { E.fused(acc, cur, wr, wc, fr, fq, lds, wid, lane); }
#undef PG8_SA
#undef PG8_SB
#undef PG8_STAGEA
#undef PG8_STAGEB
#undef PG8_LDA
#undef PG8_LDB
#undef PG8_MMA
#undef PG8_WAIT_V
#undef PG8_WAIT_L
#undef PG8_BAR
#undef PG8_SCHED
#undef PG8_AOFFS
}
}
namespace epi {
using pg8::Unit; using pg8::BM; using pg8::HALF;
__device__ __forceinline__ unsigned cvt_pk_bf16(float lo, float hi) { unsigned r; asm volatile("v_cvt_pk_bf16_f32 %0, %1, %2" : "=v"(r) : "v"(lo), "v"(hi)); return r; }
__device__ __forceinline__ u32x4 pack8(const f32x4 a, const f32x4 b) { u32x4 w; w.x = cvt_pk_bf16(a[0], a[1]); w.y = cvt_pk_bf16(a[2], a[3]); w.z = cvt_pk_bf16(b[0], b[1]); w.w = cvt_pk_bf16(b[2], b[3]); return w; }

struct EpiInProj {
    static constexpr bool PERM = true, AFTER_DRAIN = false;
    const float* rstd1; bf16* cq; bf16* ckv; bf16* ussm; bf16* conva; bf16* convg; float* ssqq; float* ssqkv; float* ssqpe;
    __device__ __forceinline__ void operator()(const f32x4 (&acc)[2][2][4][2], const Unit& u, int wr, int wc, int fr, int fq) const {
        const int cl0 = wc * 32 + 8 * fq;
#pragma unroll
        for (int ai = 0; ai < 2; ++ai)
#pragma unroll
            for (int m = 0; m < 4; ++m) {
                const int row = u.pm * BM + ai * HALF + wr * 64 + m * 16 + fr;
                const float rs = rstd1[row];
                f32x4 v[2][2];
#pragma unroll
                for (int bj = 0; bj < 2; ++bj)
#pragma unroll
                    for (int n = 0; n < 2; ++n) v[bj][n] = acc[ai][bj][m][n] * rs;
                if (u.pn == 0 || u.pn == 1) {
                    bf16* dst = (u.pn == 0) ? cq : ckv;
                    float s0 = 0.f, s1 = 0.f;
#pragma unroll
                    for (int n = 0; n < 2; ++n)
#pragma unroll
                        for (int i = 0; i < 4; ++i) { s0 += v[0][n][i] * v[0][n][i]; s1 += v[1][n][i] * v[1][n][i]; }
                    s0 += __shfl_xor(s0, 16); s0 += __shfl_xor(s0, 32); s1 += __shfl_xor(s1, 16); s1 += __shfl_xor(s1, 32);
#pragma unroll
                    for (int bj = 0; bj < 2; ++bj) *(u32x4*)(dst + (size_t)row * 256 + bj * HALF + cl0) = pack8(v[bj][0], v[bj][1]);
                    if (fq == 0) {
                        if (u.pn == 0) ssqq[row * 4 + wc] = s0 + s1;
                        else { ssqkv[row * 4 + wc] = s0; if (wc == 0) ssqpe[row] = s1; }
                    }
                } else if (u.pn == 2) {
                    const int b = row >> 11, t = row & 2047, nch = t >> 6, j = t & 63;
#pragma unroll
                    for (int bj = 0; bj < 2; ++bj) { const int c = bj * HALF + cl0, gg = c >> 4, c0 = c & 15;
                        *(u32x4*)(ussm + ((((size_t)(b * 16 + gg) * 64 + j) * 32 + nch) * 16 + c0)) = pack8(v[bj][0], v[bj][1]); }
                } else {
                    bf16* dst = (u.pn == 3) ? conva : convg;
#pragma unroll
                    for (int bj = 0; bj < 2; ++bj) *(u32x4*)(dst + (size_t)row * 256 + bj * HALF + cl0) = pack8(v[bj][0], v[bj][1]);
                }
            }
    }
};

struct EpiUp {
    static constexpr bool PERM = true, AFTER_DRAIN = false;
    const float* ssq4; float inv_width; bf16* out;
    __device__ __forceinline__ void operator()(const f32x4 (&acc)[2][2][4][2], const Unit& u, int wr, int wc, int fr, int fq) const {
        const int col0 = u.pn * BM + wc * 32 + 8 * fq;
#pragma unroll
        for (int ai = 0; ai < 2; ++ai)
#pragma unroll
            for (int m = 0; m < 4; ++m) {
                const int row = u.pm * BM + ai * HALF + wr * 64 + m * 16 + fr;
                const f32x4 q = *(const f32x4*)(ssq4 + row * 4);
                const float rs = 1.0f / sqrtf(((q[0] + q[1]) + (q[2] + q[3])) * inv_width + EPS);
#pragma unroll
                for (int bj = 0; bj < 2; ++bj) *(u32x4*)(out + (size_t)row * 1024 + col0 + bj * HALF) = pack8(acc[ai][bj][m][0] * rs, acc[ai][bj][m][1] * rs);
            }
    }
};

struct EpiGlu {
    static constexpr bool PERM = true, AFTER_DRAIN = true;
    const bf16* z; bf16* y;
    __device__ __forceinline__ void fused(f32x4 (&acc)[2][2][4][2], const Unit& u, int wr, int wc, int fr, int fq, LAS unsigned char* lds, int wid, int lane) const {
        LAS float* P = (LAS float*)lds;
        const int col0 = wc * 32 + 8 * fq;
#pragma unroll
        for (int ai = 0; ai < 2; ++ai)
#pragma unroll
            for (int m = 0; m < 4; ++m) {
                const int rl = ai * HALF + wr * 64 + m * 16 + fr, row = u.pm * BM + rl;
                float s = 0.f;
#pragma unroll
                for (int bj = 0; bj < 2; ++bj) {
                    const u32x4 zw = *(const u32x4*)(z + (size_t)row * 256 + bj * HALF + col0);
                    const float zf[8] = {bflo(zw.x), bfhi(zw.x), bflo(zw.y), bfhi(zw.y), bflo(zw.z), bfhi(zw.z), bflo(zw.w), bfhi(zw.w)};
#pragma unroll
                    for (int n = 0; n < 2; ++n)
#pragma unroll
                        for (int i = 0; i < 4; ++i) { const float o = zf[n * 4 + i] * sigmoidf_(acc[ai][bj][m][n][i]); acc[ai][bj][m][n][i] = o; s += o * o; }
                }
                s += __shfl_xor(s, 16); s += __shfl_xor(s, 32);
                if (fq == 0) P[rl * 4 + wc] = s;
            }
        asm volatile("s_waitcnt lgkmcnt(0)" ::: "memory"); __builtin_amdgcn_s_barrier(); asm volatile("" ::: "memory");
#pragma unroll
        for (int ai = 0; ai < 2; ++ai)
#pragma unroll
            for (int m = 0; m < 4; ++m) {
                const int rl = ai * HALF + wr * 64 + m * 16 + fr, row = u.pm * BM + rl;
                const f32x4 q = *(const LAS f32x4*)(P + rl * 4);
                const float rs = 1.0f / sqrtf(((q[0] + q[1]) + (q[2] + q[3])) * (1.0f / 256.0f) + EPS);
#pragma unroll
                for (int bj = 0; bj < 2; ++bj) *(u32x4*)(y + (size_t)row * 1024 + 512 + bj * HALF + col0) = pack8(acc[ai][bj][m][0] * rs, acc[ai][bj][m][1] * rs);
            }
        asm volatile("s_waitcnt lgkmcnt(0)" ::: "memory"); __builtin_amdgcn_s_barrier(); asm volatile("" ::: "memory");
    }
};

struct EpiResidual {
    static constexpr bool PERM = false, AFTER_DRAIN = false;
    const float* xin; float* xout;
    __device__ __forceinline__ void operator()(const f32x4 (&acc)[2][2][4][2], const Unit& u, int wr, int wc, int fr, int fq) const {
        const int col0 = u.pn * BM + wc * 32 + 4 * fq;
#pragma unroll
        for (int ai = 0; ai < 2; ++ai)
#pragma unroll
            for (int m = 0; m < 4; ++m) {
                const size_t off = (size_t)(u.pm * BM + ai * HALF + wr * 64 + m * 16 + fr) * 1024 + col0;
#pragma unroll
                for (int bj = 0; bj < 2; ++bj)
#pragma unroll
                    for (int n = 0; n < 2; ++n) { const f32x4 b = *(const f32x4*)(xin + off + bj * HALF + n * 16); *(f32x4*)(xout + off + bj * HALF + n * 16) = b + acc[ai][bj][m][n]; }
            }
    }
};
}

struct MoeSched {
    const LAS int* tab; const int* toklist; int G, c; bool gather;
    __device__ __forceinline__ int expert_of(int pmb) const { int e = 0;
        for (int k = 1; k < 32; ++k) e += (tab[32 + k] <= pmb) ? 1 : 0;
        return e; }
    __device__ bool next(int i, pg8::Unit& u) const {
        const int idx = i * G + c, nunits = tab[64] * 4; if (idx >= nunits) return false;
        const int pmb = idx >> 2, j = idx & 3; const int e = expert_of(pmb);
        u.pm = pmb; u.pn = e * 4 + j; return true;
    }
    __device__ __forceinline__ unsigned arow(const pg8::Unit& u, int rloc) const {
        if (!gather) return (unsigned)(u.pm * 256 + rloc);
        const int e = u.pn >> 2; const int s = (u.pm - tab[32 + e]) * 256 + rloc;
        return (s < tab[e]) ? (unsigned)toklist[e * 16384 + s] : 0u;
    }
};
namespace epi {
struct EpiMoe1 {
    static constexpr bool PERM = true, AFTER_DRAIN = false;
    const LAS int* tab; const int* toklist; const float* rstd2; bf16* H;
    __device__ __forceinline__ void operator()(const f32x4 (&acc)[2][2][4][2], const Unit& u, int wr, int wc, int fr, int fq) const {
        const int e = u.pn >> 2, j = u.pn & 3, cnt = tab[e], s0 = (u.pm - tab[32 + e]) * 256;
#pragma unroll
        for (int ai = 0; ai < 2; ++ai)
#pragma unroll
            for (int m = 0; m < 4; ++m) {
                const int rl = ai * HALF + wr * 64 + m * 16 + fr, s = s0 + rl;
                float rs = 0.f; if (s < cnt) rs = rstd2[toklist[e * 16384 + s]];
                f32x4 o[2];
#pragma unroll
                for (int n = 0; n < 2; ++n)
#pragma unroll
                    for (int i = 0; i < 4; ++i) { const float a = acc[ai][0][m][n][i] * rs, b = acc[ai][1][m][n][i] * rs; o[n][i] = a * sigmoidf_(a) * b; }
                *(u32x4*)(H + (size_t)(u.pm * 256 + rl) * 512 + j * 128 + wc * 32 + 8 * fq) = pack8(o[0], o[1]);
            }
    }
};
struct EpiMoe2 {
    static constexpr bool PERM = true, AFTER_DRAIN = false;
    const LAS int* tab; const float* gatelist; bf16* Y;
    __device__ __forceinline__ void operator()(const f32x4 (&acc)[2][2][4][2], const Unit& u, int wr, int wc, int fr, int fq) const {
        const int e = u.pn >> 2, j = u.pn & 3, cnt = tab[e], s0 = (u.pm - tab[32 + e]) * 256;
        const int col0 = j * 256 + wc * 32 + 8 * fq;
#pragma unroll
        for (int ai = 0; ai < 2; ++ai)
#pragma unroll
            for (int m = 0; m < 4; ++m) {
                const int rl = ai * HALF + wr * 64 + m * 16 + fr, s = s0 + rl;
                float gt = 0.f; if (s < cnt) gt = gatelist[e * 16384 + s];
#pragma unroll
                for (int bj = 0; bj < 2; ++bj) *(u32x4*)(Y + (size_t)(u.pm * 256 + rl) * 1024 + col0 + bj * HALF) = pack8(acc[ai][bj][m][0] * gt, acc[ai][bj][m][1] * gt);
            }
    }
};
}
#define XB_TMO      128
#define XB_XCNT(j)  (256  + 64 * (j))
#define XB_XSUB(j)  (1280 + 64 * (j))
#define XB_XGEN(j)  (2304 + 64 * (j))
#define XB_TOP      3328
#define XB_TOPGEN   3392
#define XCD_BAR_WORDS 3456
#define XB_SPIN_CAP (1u << 18)
__device__ __forceinline__ unsigned xb_ld(unsigned* p)              { return __hip_atomic_load(p, __ATOMIC_RELAXED, __HIP_MEMORY_SCOPE_AGENT); }
__device__ __forceinline__ unsigned xb_add(unsigned* p, unsigned v) { return __hip_atomic_fetch_add(p, v, __ATOMIC_RELAXED, __HIP_MEMORY_SCOPE_AGENT); }
__device__ __forceinline__ unsigned xb_xcc_id() { return (unsigned)__builtin_amdgcn_s_getreg((3 << 11) | 20) & 0xFu; }
#define XB_SPIN(cond, bar) do { unsigned _sp = 0; while (cond) { __builtin_amdgcn_s_sleep(1); \
    if ((++_sp & 255u) == 0u) { if (xb_ld(&(bar)[XB_TMO])) break; if (_sp > XB_SPIN_CAP) { atomicAdd(&(bar)[XB_TMO], 1u); break; } } } } while (0)
struct XcdBarrier { unsigned* bar; unsigned x; volatile LAS unsigned* st; };
__device__ __forceinline__ XcdBarrier xcd_barrier_post(unsigned* bar, volatile LAS unsigned* st) {
    XcdBarrier b; b.bar = bar; b.x = xb_xcc_id(); b.st = st;
    if (threadIdx.x == 0) (void)xb_add(&bar[XB_XCNT(b.x)], 1u);
    return b;
}
__device__ __forceinline__ void xcd_barrier_complete(unsigned* bar, unsigned x, unsigned& nloc, unsigned& nx) {
    const unsigned G = gridDim.x * gridDim.y * gridDim.z;
    unsigned sum, cnt, mine, sp = 0u;
    for (;;) {
        sum = 0u; cnt = 0u; mine = 0u;
#pragma unroll
        for (unsigned j = 0; j < 16; ++j) { const unsigned c = xb_ld(&bar[XB_XCNT(j)]); sum += c; cnt += (c > 0u) ? 1u : 0u; mine = (j == x) ? c : mine; }
        if (sum == G) break;
        __builtin_amdgcn_s_sleep(1);
        if ((++sp & 255u) == 0u) { if (xb_ld(&bar[XB_TMO])) break; if (sp > XB_SPIN_CAP) { atomicAdd(&bar[XB_TMO], 1u); break; } }
    }
    nloc = mine > 0u ? mine : 1u; nx = cnt > 0u ? cnt : 1u;
}
__device__ __forceinline__ void xcd_barrier(const XcdBarrier& b) {
    asm volatile("s_waitcnt vmcnt(0)" ::: "memory");
    __syncthreads();
    if (threadIdx.x == 0) {
        unsigned* bar = b.bar;
        __builtin_amdgcn_s_waitcnt(0);
        unsigned nloc = b.st[0], nx = b.st[1];
        if (nloc == 0u) { xcd_barrier_complete(bar, b.x, nloc, nx); b.st[0] = nloc; b.st[1] = nx; }
        const unsigned old = xb_add(&bar[XB_XSUB(b.x)], 1u);
        const unsigned gen = old / nloc;
        if (old + 1u == (gen + 1u) * nloc) {
            __builtin_amdgcn_fence(__ATOMIC_RELEASE, "agent");
            asm volatile("s_waitcnt vmcnt(0)" ::: "memory");
            const unsigned og = xb_add(&bar[XB_TOP], 1u);
            const unsigned tg = og / nx;
            if (og + 1u == (tg + 1u) * nx) xb_add(&bar[XB_TOPGEN], 1u);
            else XB_SPIN(xb_ld(&bar[XB_TOPGEN]) == tg, bar);
            __builtin_amdgcn_fence(__ATOMIC_ACQUIRE, "agent");
            xb_add(&bar[XB_XGEN(b.x)], 1u);
            asm volatile("s_waitcnt vmcnt(0)" ::: "memory");
        } else {
            XB_SPIN(xb_ld(&bar[XB_XGEN(b.x)]) == gen, bar);
            __builtin_amdgcn_fence(__ATOMIC_ACQUIRE, "agent");
            asm volatile("s_waitcnt vmcnt(0)" ::: "memory");
        }
    }
    __syncthreads();
}

struct Args {
    const float* x; const int* pos; const float* mix_norm; const float* w_in; const float* q_a_norm; const float* w_uq; const float* kv_a_norm; const float* w_ukv;
    const float* q_norm; const float* k_norm; const float* lam_re; const float* lam_im; const float* b_re; const float* b_im; const float* c_re; const float* c_im;
    const float* ssm_d; const float* log_dt; const float* w_glu; const float* dw_w; const float* dw_b; const float* ln_w; const float* ln_b; const float* out_norm;
    const float* w_out; const float* ffn_norm; const float* w_grp; const float* b_grp; const float* w_exp; const float* b_exp; const float* w1; const float* w3; const float* w2;
    float* out; unsigned char* ws;
};
typedef const Args __attribute__((address_space(4))) CArgs;
struct Frame {
    LAS unsigned char* lds; int tid, lane, wave, vcu, G;
};

__device__ __forceinline__ void transpose_item(const float* W, int ldw, int k0, int n0, const float* gain, bf16* WT, int dpitch, int dst_row0, LAS float* scr, int lane) {
#pragma unroll 8
    for (int i = 0; i < 32; ++i) { const int kk = 2 * i + (lane >> 5); float v = W[(size_t)(k0 + kk) * ldw + n0 + (lane & 31)]; if (gain) v *= gain[k0 + kk]; scr[kk * 33 + (lane & 31)] = v; }
    asm volatile("s_waitcnt lgkmcnt(0)" ::: "memory");
    const int c = lane & 7;
#pragma unroll
    for (int j = 0; j < 4; ++j) { const int n = (lane >> 3) + 8 * j; const LAS float* s = scr + (8 * c) * 33 + n;
        u32x4 o; o.x = pk2(s[0 * 33], s[1 * 33]); o.y = pk2(s[2 * 33], s[3 * 33]); o.z = pk2(s[4 * 33], s[5 * 33]); o.w = pk2(s[6 * 33], s[7 * 33]);
        *(u32x4*)(WT + (size_t)(dst_row0 + n) * dpitch + k0 + 8 * c) = o; }
    asm volatile("s_waitcnt lgkmcnt(0)" ::: "memory");
}

__device__ __forceinline__ void sincos_d(double x, double& s, double& c) {
    const double q = rint(x * 0.63661977236758134308); const int iq = (int)q;
    double r = fma(-q, 1.57079632679489655800, x); r = fma(-q, 6.12323399573676603587e-17, r);
    const double r2 = r * r;
    const double sp = r * (1.0 + r2 * (-1.0 / 6 + r2 * (1.0 / 120 + r2 * (-1.0 / 5040 + r2 * (1.0 / 362880 + r2 * (-1.0 / 39916800 + r2 * (1.0 / 6227020800.0)))))));
    const double cp = 1.0 + r2 * (-0.5 + r2 * (1.0 / 24 + r2 * (-1.0 / 720 + r2 * (1.0 / 40320 + r2 * (-1.0 / 3628800 + r2 * (1.0 / 479001600 + r2 * (-1.0 / 87178291200.0)))))));
    switch (iq & 3) { case 0: s = sp; c = cp; break; case 1: s = cp; c = -sp; break; case 2: s = -sp; c = -cp; break; default: s = -cp; c = sp; break; }
}
__device__ __forceinline__ void ssm_tables(const Frame& F, CArgs& a, int l, int g) {
    LAS float* PW = (LAS float*)F.lds;
    LAS float* BB = (LAS float*)(F.lds + 33280);
    LAS float* CC = (LAS float*)(F.lds + 41472);
    const int lg = l * SSG + g;
    const double dt = exp((double)a.log_dt[lg]);
    for (int idx = F.tid; idx < 64 * 65; idx += 512) { const int p = idx / 65, d = idx % 65;
        const double re = a.lam_re[lg * 64 + p], im = a.lam_im[lg * 64 + p];
        const double mag = exp(re * dt * d), ang = im * dt * d; double sn, cs; sincos_d(ang, sn, cs);
        PW[idx * 2] = (float)(mag * cs); PW[idx * 2 + 1] = (float)(mag * sn); }
    for (int idx = F.tid; idx < 64 * 16; idx += 512) { const int p = idx >> 4, c = idx & 15;
        const double re = a.lam_re[lg * 64 + p], im = a.lam_im[lg * 64 + p];
        double sn, cs; sincos_d(im * dt, sn, cs);
        const double mag = exp(re * dt), lbr = mag * cs - 1.0, lbi = mag * sn;
        const double den = re * re + im * im; const double fr_ = (lbr * re + lbi * im) / den, fi_ = (lbi * re - lbr * im) / den;
        const double br = a.b_re[((size_t)lg * 64 + p) * 16 + c], bi = a.b_im[((size_t)lg * 64 + p) * 16 + c];
        BB[idx * 2] = (float)(fr_ * br - fi_ * bi); BB[idx * 2 + 1] = (float)(fr_ * bi + fi_ * br); }
    for (int idx = F.tid; idx < 16 * 64; idx += 512) { CC[idx * 2] = a.c_re[(size_t)lg * 1024 + idx]; CC[idx * 2 + 1] = a.c_im[(size_t)lg * 1024 + idx]; }
    __syncthreads();
    unsigned char* tab = a.ws + WS_SSMTAB + (size_t)l * SSMTAB_LAYER;
    bf16* KD = (bf16*)(tab + ST_KD) + (size_t)g * 64 * 256;
    for (int idx = F.tid; idx < 64 * 256; idx += 512) { const int d = idx >> 8, c = (idx >> 4) & 15, c2 = idx & 15; float s = 0.f;
        for (int p = 0; p < 64; ++p) { const float cr = CC[(c * 64 + p) * 2], ci = CC[(c * 64 + p) * 2 + 1], pr = PW[(p * 65 + d) * 2], pi = PW[(p * 65 + d) * 2 + 1];
            const float tr = cr * pr - ci * pi, ti = cr * pi + ci * pr; s += tr * BB[(p * 16 + c2) * 2] - ti * BB[(p * 16 + c2) * 2 + 1]; }
        if (d == 0 && c == c2) s += a.ssm_d[lg * 16 + c];
        KD[idx] = (bf16)f2bf(s); }
    bf16* WST = (bf16*)(tab + ST_WST) + (size_t)g * 4 * 64 * 512;
    for (int idx = F.tid; idx < 4 * 64 * 512; idx += 512) { const int jj = idx & 7, ln = (idx >> 3) & 63, ks = (idx >> 9) & 63, rt = idx >> 15;
        const int rho = 32 * rt + (ln & 31), p = rho >> 1, ri = rho & 1, j = ks, c2 = 8 * (ln >> 5) + jj;
        const float pr = PW[(p * 65 + 63 - j) * 2], pi = PW[(p * 65 + 63 - j) * 2 + 1], br = BB[(p * 16 + c2) * 2], bi = BB[(p * 16 + c2) * 2 + 1];
        WST[idx] = (bf16)f2bf(ri ? (pr * bi + pi * br) : (pr * br - pi * bi)); }
    bf16* VIN = (bf16*)(tab + ST_VIN) + (size_t)g * 32 * 8 * 512;
    for (int idx = F.tid; idx < 32 * 8 * 512; idx += 512) { const int jj = idx & 7, ln = (idx >> 3) & 63, ks = (idx >> 9) & 7, rt = idx >> 12;
        const int row = 32 * rt + (ln & 31), i = row >> 4, c = row & 15, k = 16 * ks + 8 * (ln >> 5) + jj, p = k >> 1, ri = k & 1;
        const float cr = CC[(c * 64 + p) * 2], ci = CC[(c * 64 + p) * 2 + 1], pr = PW[(p * 65 + i + 1) * 2], pi = PW[(p * 65 + i + 1) * 2 + 1];
        VIN[idx] = (bf16)f2bf(ri ? -(cr * pi + ci * pr) : (cr * pr - ci * pi)); }
    float* LAM = (float*)(tab + ST_LAM) + g * 128;
    if (F.tid < 64) { LAM[F.tid * 2] = PW[(F.tid * 65 + 64) * 2]; LAM[F.tid * 2 + 1] = PW[(F.tid * 65 + 64) * 2 + 1]; }
    __syncthreads();
}

__device__ __forceinline__ void phase_prologue(const Frame& F, CArgs& a) {
    if (F.vcu < 2 * SSG) ssm_tables(F, a, F.vcu / SSG, F.vcu % SSG);
    LAS float* scr = (LAS float*)(F.lds + F.wave * 16384);
    const int gw = F.vcu * 8 + F.wave, NGW = F.G * 8;
    constexpr int I_IN = 37 * 16, I_UQ = 24 * 4, I_UKV = 32 * 2, I_GLU = 8 * 4, I_OUT = 32 * 16, I_W1 = 32 * 16 * 16, I_W2 = 32 * 32 * 8;
    constexpr int I_LAYER = I_IN + I_UQ + I_UKV + I_GLU + I_OUT + 2 * I_W1 + I_W2;
    for (int it = gw; it < 2 * I_LAYER; it += NGW) {
        const int l = it / I_LAYER; int r = it % I_LAYER;
        if (r < I_IN) { const int nb = r / 16, kb = r % 16, n0 = nb * 32; const int dr = n0 < 416 ? n0 : n0 + 96;
            transpose_item(a.w_in + (size_t)l * 1024 * INPROJ, INPROJ, kb * 64, n0, a.mix_norm + l * 1024, (bf16*)(a.ws + WS_WIN) + (size_t)l * 1280 * 1024, 1024, dr, scr, F.lane); continue; } r -= I_IN;
        if (r < I_UQ) { const int nb = r / 4, kb = r % 4; const int dr = (nb / 3) * 128 + (nb % 3) * 32;
            transpose_item(a.w_uq + (size_t)l * 256 * 768, 768, kb * 64, nb * 32, a.q_a_norm + l * 256, (bf16*)(a.ws + WS_WUQ) + (size_t)l * 1024 * 256, 256, dr, scr, F.lane); continue; } r -= I_UQ;
        if (r < I_UKV) { const int nb = r / 2, kb = r % 2;
            transpose_item(a.w_ukv + (size_t)l * 128 * 1024, 1024, kb * 64, nb * 32, a.kv_a_norm + l * 128, (bf16*)(a.ws + WS_WUKV) + (size_t)l * 1024 * 256, 256, nb * 32, scr, F.lane); continue; } r -= I_UKV;
        if (r < I_GLU) { const int nb = r / 4, kb = r % 4;
            transpose_item(a.w_glu + (size_t)l * 256 * 256, 256, kb * 64, nb * 32, nullptr, (bf16*)(a.ws + WS_WGLU) + (size_t)l * 256 * 256, 256, nb * 32, scr, F.lane); continue; } r -= I_GLU;
        if (r < I_OUT) { const int nb = r / 16, kb = r % 16;
            transpose_item(a.w_out + (size_t)l * 1024 * 1024, 1024, kb * 64, nb * 32, a.out_norm + l * 1024, (bf16*)(a.ws + WS_WOUT) + (size_t)l * 1024 * 1024, 1024, nb * 32, scr, F.lane); continue; } r -= I_OUT;
        if (r < 2 * I_W1) { const int which = r / I_W1; r %= I_W1; const int e = r / 256, q = r % 256, nb = q / 16, kb = q % 16;
            const float* W = (which ? a.w3 : a.w1) + ((size_t)l * NEXP + e) * 1024 * 512; const int dr = e * 1024 + (nb / 4) * 256 + which * 128 + (nb % 4) * 32;
            transpose_item(W, 512, kb * 64, nb * 32, a.ffn_norm + l * 1024, (bf16*)(a.ws + WS_W13) + (size_t)l * NEXP * 1024 * 1024, 1024, dr, scr, F.lane); continue; } r -= 2 * I_W1;
        { const int e = r / 256, q = r % 256, nb = q / 8, kb = q % 8;
            transpose_item(a.w2 + ((size_t)l * NEXP + e) * 512 * 1024, 1024, kb * 64, nb * 32, nullptr, (bf16*)(a.ws + WS_W2) + (size_t)l * NEXP * 1024 * 512, 512, e * 1024 + nb * 32, scr, F.lane); }
    }
    const int gt = F.vcu * 512 + F.tid, NGT = F.G * 512;
    for (int l = 0; l < 2; ++l) {
        u32x4 z4 = (u32x4){0u, 0u, 0u, 0u};
        { u32x4* p = (u32x4*)((bf16*)(a.ws + WS_WIN) + ((size_t)l * 1280 + 416) * 1024); for (int i = gt; i < 96 * 128; i += NGT) p[i] = z4; }
        { bf16* base = (bf16*)(a.ws + WS_WUQ) + (size_t)l * 1024 * 256; for (int i = gt; i < 8 * 32 * 32; i += NGT) { const int h = i >> 10, rr = (i >> 5) & 31, cc = i & 31; *(u32x4*)(base + (size_t)(h * 128 + 96 + rr) * 256 + cc * 8) = z4; } }
        { bf16* base = (bf16*)(a.ws + WS_WUKV) + (size_t)l * 1024 * 256; for (int i = gt; i < 1024 * 16; i += NGT) { const int rr = i >> 4, cc = i & 15; *(u32x4*)(base + (size_t)rr * 256 + 128 + cc * 8) = z4; } }
    }
    for (int i = gt; i < 2 * 1024 * 40; i += NGT) { const int l = i / (1024 * 40), k = (i / 40) % 1024, j = i % 40; float v = 0.f;
        if (j < 4) v = a.w_grp[((size_t)l * 1024 + k) * 4 + j]; else if (j < 36) v = a.w_exp[((size_t)l * 1024 + k) * 32 + (j - 4)];
        ((float*)(a.ws + WS_ROUTER))[i] = v * a.ffn_norm[l * 1024 + k]; }
    for (int i = gt; i < NTOK * 16; i += NGT) { const int t = i >> 4, j = i & 15;
        const float inv = (float)exp(-(double)(2 * j) / 32.0 * 9.210340371976184); const float ang = (float)a.pos[t] * inv;
        double sn, cs; sincos_d((double)ang, sn, cs);
        ((float*)(a.ws + WS_COS))[i] = (float)cs; ((float*)(a.ws + WS_SIN))[i] = (float)sn; }
    for (int m = gw; m < NTOK; m += NGW) {
        const f32x4* xr = (const f32x4*)(a.x + (size_t)m * DM) + F.lane; f32x4 v[4]; float s = 0.f;
#pragma unroll
        for (int j = 0; j < 4; ++j) { v[j] = xr[64 * j]; s += (v[j].x * v[j].x + v[j].y * v[j].y) + (v[j].z * v[j].z + v[j].w * v[j].w); }
        s = wave_sum(s);
        u32x2* o = (u32x2*)((bf16*)(a.ws + WS_XB) + (size_t)m * DM) + F.lane;
#pragma unroll
        for (int j = 0; j < 4; ++j) { u32x2 w; w.x = pk2(v[j].x, v[j].y); w.y = pk2(v[j].z, v[j].w); o[64 * j] = w; }
        if (F.lane == 0) ((float*)(a.ws + WS_SMALL + SM_RSTD1))[m] = 1.0f / sqrtf(s * (1.0f / DM) + EPS);
    }
}
__device__ __forceinline__ void phase_prep(const Frame& F, CArgs& a, int l) {
    const bf16* qraw = (const bf16*)(a.ws + WS_QRAW); const bf16* kvraw = (const bf16*)(a.ws + WS_KVRAW); const bf16* ckv = (const bf16*)(a.ws + WS_CKV);
    bf16* Q = (bf16*)(a.ws + WS_Q); bf16* K = (bf16*)(a.ws + WS_K); bf16* V = (bf16*)(a.ws + WS_V);
    const float* cosT = (const float*)(a.ws + WS_COS); const float* sinT = (const float*)(a.ws + WS_SIN);
    const float* gq = a.q_norm + l * QKH; const float* gk = a.k_norm + l * QKH;
    const int lane = F.lane, head = lane >> 3, s = lane & 7;
    const float QSCALE = 0.10206207261596577f * 1.4426950408889634f;
    f32x4 gqv[3], gkv[3];
#pragma unroll
    for (int i = 0; i < 3; ++i) { gqv[i] = *(const f32x4*)(gq + 32 * i + 4 * s); gkv[i] = *(const f32x4*)(gk + 32 * i + 4 * s); }
    const int gw = F.vcu * 8 + F.wave, NGW = F.G * 8;
    for (int t = gw; t < NTOK; t += NGW) {
        const f32x4 cs = *(const f32x4*)(cosT + (size_t)t * 16 + 4 * (s & 3)), sn = *(const f32x4*)(sinT + (size_t)t * 16 + 4 * (s & 3));
        f32x4 v[3]; float ss = 0.f;
#pragma unroll
        for (int i = 0; i < 3; ++i) { const u32x2 w = *(const u32x2*)(qraw + (size_t)t * 1024 + head * 128 + 32 * i + 4 * s);
            v[i] = (f32x4){bflo(w.x), bfhi(w.x), bflo(w.y), bfhi(w.y)}; ss += (v[i].x * v[i].x + v[i].y * v[i].y) + (v[i].z * v[i].z + v[i].w * v[i].w); }
        ss += __shfl_xor(ss, 1); ss += __shfl_xor(ss, 2); ss += __shfl_xor(ss, 4);
        float rs = 1.0f / sqrtf(ss * (1.0f / 96.0f) + EPS);
#pragma unroll
        for (int i = 0; i < 3; ++i) v[i] = v[i] * rs * gqv[i];
        {
            f32x4 o; f32x4 pv;
#pragma unroll
            for (int e = 0; e < 4; ++e) pv[e] = __shfl_xor(v[2][e], 4);
#pragma unroll
            for (int e = 0; e < 4; ++e) o[e] = (s < 4) ? (v[2][e] * cs[e] - pv[e] * sn[e]) : (pv[e] * sn[e] + v[2][e] * cs[e]);
            v[2] = o;
        }
#pragma unroll
        for (int i = 0; i < 3; ++i) { u32x2 w; w.x = pk2(v[i].x * QSCALE, v[i].y * QSCALE); w.y = pk2(v[i].z * QSCALE, v[i].w * QSCALE);
            *(u32x2*)(Q + (size_t)t * 768 + head * 96 + 32 * i + 4 * s) = w; }
        f32x4 kk[3]; float ks = 0.f;
#pragma unroll
        for (int i = 0; i < 2; ++i) { const u32x2 w = *(const u32x2*)(kvraw + (size_t)t * 1024 + head * 128 + 32 * i + 4 * s);
            kk[i] = (f32x4){bflo(w.x), bfhi(w.x), bflo(w.y), bfhi(w.y)}; ks += (kk[i].x * kk[i].x + kk[i].y * kk[i].y) + (kk[i].z * kk[i].z + kk[i].w * kk[i].w); }
        { const u32x2 w = *(const u32x2*)(ckv + (size_t)t * 256 + 128 + 4 * s);
            kk[2] = (f32x4){bflo(w.x), bfhi(w.x), bflo(w.y), bfhi(w.y)}; ks += (kk[2].x * kk[2].x + kk[2].y * kk[2].y) + (kk[2].z * kk[2].z + kk[2].w * kk[2].w); }
        ks += __shfl_xor(ks, 1); ks += __shfl_xor(ks, 2); ks += __shfl_xor(ks, 4);
        rs = 1.0f / sqrtf(ks * (1.0f / 96.0f) + EPS);
#pragma unroll
        for (int i = 0; i < 3; ++i) kk[i] = kk[i] * rs * gkv[i];
        {
            f32x4 o; f32x4 pv;
#pragma unroll
            for (int e = 0; e < 4; ++e) pv[e] = __shfl_xor(kk[2][e], 4);
#pragma unroll
            for (int e = 0; e < 4; ++e) o[e] = (s < 4) ? (kk[2][e] * cs[e] - pv[e] * sn[e]) : (pv[e] * sn[e] + kk[2][e] * cs[e]);
            kk[2] = o;
        }
#pragma unroll
        for (int i = 0; i < 3; ++i) { u32x2 w; w.x = pk2(kk[i].x, kk[i].y); w.y = pk2(kk[i].z, kk[i].w);
            *(u32x2*)(K + (size_t)t * 768 + head * 96 + 32 * i + 4 * s) = w; }
#pragma unroll
        for (int i = 0; i < 2; ++i) { const u32x2 w = *(const u32x2*)(kvraw + (size_t)t * 1024 + head * 128 + 64 + 32 * i + 4 * s);
            *(u32x2*)(V + (size_t)t * 512 + head * 64 + 32 * i + 4 * s) = w; }
    }
}

__device__ __forceinline__ void conv_unit(const Frame& F, CArgs& a, int l, int unit) {
    LAS float* UL = (LAS float*)F.lds;
    LAS float* WL = (LAS float*)(F.lds + 94 * 256 * 4);
    const bf16* ca = (const bf16*)(a.ws + WS_CONVA); const bf16* cg = (const bf16*)(a.ws + WS_CONVG); bf16* Y = (bf16*)(a.ws + WS_Y);
    const int b = unit >> 5, t0 = (unit & 31) * 64;
    __syncthreads();
    for (int idx = F.tid; idx < 94 * 64; idx += 512) { const int r = idx >> 6, c4 = idx & 63, t = t0 - 30 + r;
        f32x4 u = (f32x4){0.f, 0.f, 0.f, 0.f};
        if (t >= 0) { const size_t off = ((size_t)(b * SEQ + t)) * 256 + c4 * 4; const u32x2 wa = *(const u32x2*)(ca + off), wg = *(const u32x2*)(cg + off);
            u.x = bflo(wa.x) * sigmoidf_(bflo(wg.x)); u.y = bfhi(wa.x) * sigmoidf_(bfhi(wg.x)); u.z = bflo(wa.y) * sigmoidf_(bflo(wg.y)); u.w = bfhi(wa.y) * sigmoidf_(bfhi(wg.y)); }
        *(LAS f32x4*)(UL + r * 256 + c4 * 4) = u; }
    for (int idx = F.tid; idx < 31 * 64; idx += 512) *(LAS f32x4*)(WL + idx * 4) = *(const f32x4*)(a.dw_w + (size_t)l * 31 * 256 + idx * 4);
    __syncthreads();
    const int c0 = F.lane * 4;
    const f32x4 bias = *(const f32x4*)(a.dw_b + l * 256 + c0), lw = *(const f32x4*)(a.ln_w + l * 256 + c0), lb = *(const f32x4*)(a.ln_b + l * 256 + c0);
    for (int tt = 0; tt < 8; ++tt) { const int tok = F.wave * 8 + tt;
        f32x4 acc = bias;
#pragma unroll
        for (int k = 0; k < 31; ++k) acc += *(const LAS f32x4*)(WL + k * 256 + c0) * *(const LAS f32x4*)(UL + (tok + k) * 256 + c0);
        const float mean = wave_sum((acc.x + acc.y) + (acc.z + acc.w)) * (1.0f / 256.0f);
        const f32x4 dv = acc - mean;
        const float var = wave_sum((dv.x * dv.x + dv.y * dv.y) + (dv.z * dv.z + dv.w * dv.w)) * (1.0f / 256.0f);
        const float rstd = 1.0f / sqrtf(var + 1e-5f);
        f32x4 yv = dv * rstd * lw + lb;
#pragma unroll
        for (int e = 0; e < 4; ++e) yv[e] = yv[e] * sigmoidf_(yv[e]);
        const float ms = wave_sum((yv.x * yv.x + yv.y * yv.y) + (yv.z * yv.z + yv.w * yv.w)) * (1.0f / 256.0f);
        const float rr = 1.0f / sqrtf(ms + EPS);
        u32x2 w; w.x = pk2(yv.x * rr, yv.y * rr); w.y = pk2(yv.z * rr, yv.w * rr);
        *(u32x2*)(Y + ((size_t)(b * SEQ + t0 + tok)) * 1024 + 768 + c0) = w; }
    __syncthreads();
}

__device__ __forceinline__ void ssm_unit(const Frame& F, CArgs& a, int l, int unit) {
    const int b = unit >> 4, g = unit & 15;
    LAS unsigned char* KDL = F.lds;
    LAS float* SP = (LAS float*)(F.lds + 32768);
    LAS float* SS = (LAS float*)(F.lds + 49152);
    LAS unsigned char* XIN = F.lds + 65536;
    const unsigned char* tab = a.ws + WS_SSMTAB + (size_t)l * SSMTAB_LAYER;
    const bf16* KD = (const bf16*)(tab + ST_KD) + (size_t)g * 64 * 256;
    const bf16* WST = (const bf16*)(tab + ST_WST) + (size_t)g * 4 * 64 * 512;
    const bf16* VIN = (const bf16*)(tab + ST_VIN) + (size_t)g * 32 * 8 * 512;
    const float* LAM = (const float*)(tab + ST_LAM) + g * 128;
    const bf16* U = (const bf16*)(a.ws + WS_USSM) + (size_t)(b * 16 + g) * 64 * 512;
    bf16* Z = (bf16*)(a.ws + WS_Z);
    const int lane = F.lane, w = F.wave, r32 = lane & 31, hi = lane >> 5;
    __syncthreads();
    for (int idx = F.tid; idx < 2048; idx += 512) *(LAS u32x4*)(KDL + idx * 16) = *(const u32x4*)((const unsigned char*)KD + idx * 16);
    __syncthreads();
    f32x16 acc[4];
#pragma unroll
    for (int q = 0; q < 4; ++q) acc[q] = (f32x16){};
    const int isub = r32 >> 4, cc = r32 & 15;
    for (int j = 0; j < 64; ++j) {
        const bf16x8 uf = *(const bf16x8*)(U + (size_t)j * 512 + r32 * 16 + 8 * hi);
#pragma unroll
        for (int q = 0; q < 4; ++q) { const int rt = w + 8 * q;
            if (2 * rt + 1 >= j) { const int d = 2 * rt + isub - j; bf16x8 af = (bf16x8){0, 0, 0, 0, 0, 0, 0, 0};
                if (d >= 0) af = *(const LAS bf16x8*)(KDL + ((d * 16 + cc) * 16 + 8 * hi) * 2);
                acc[q] = __builtin_amdgcn_mfma_f32_32x32x16_bf16(af, uf, acc[q], 0, 0, 0); } }
    }
    {
        const int rt4 = w & 3, kh = w >> 2; f32x16 sacc = (f32x16){};
        for (int ks = kh * 32; ks < kh * 32 + 32; ++ks) {
            const bf16x8 af = *(const bf16x8*)(WST + ((size_t)(rt4 * 64 + ks) * 64 + lane) * 8);
            const bf16x8 uf = *(const bf16x8*)(U + (size_t)ks * 512 + r32 * 16 + 8 * hi);
            sacc = __builtin_amdgcn_mfma_f32_32x32x16_bf16(af, uf, sacc, 0, 0, 0); }
        if (kh == 1) {
#pragma unroll
            for (int r = 0; r < 16; ++r) SP[(32 * rt4 + (r & 3) + 8 * (r >> 2) + 4 * hi) * 32 + r32] = sacc[r]; }
        __syncthreads();
        if (kh == 0) {
#pragma unroll
            for (int r = 0; r < 16; ++r) { const int o = (32 * rt4 + (r & 3) + 8 * (r >> 2) + 4 * hi) * 32 + r32; SS[o] = sacc[r] + SP[o]; } }
        __syncthreads();
    }
    if (F.tid < 64) { const int p = F.tid; const float lr = LAM[2 * p], li = LAM[2 * p + 1]; float sr = 0.f, si = 0.f;
        for (int n = 0; n < 32; ++n) {
            *(LAS unsigned*)(XIN + n * 272 + p * 4) = pk2(sr, si);
            const float ar = SS[(2 * p) * 32 + n], ai = SS[(2 * p + 1) * 32 + n];
            const float nr = lr * sr - li * si + ar, ni = lr * si + li * sr + ai; sr = nr; si = ni; } }
    __syncthreads();
#pragma unroll
    for (int q = 0; q < 4; ++q) { const int rt = w + 8 * q;
#pragma unroll
        for (int ks = 0; ks < 8; ++ks) {
            const bf16x8 af = *(const bf16x8*)(VIN + ((size_t)(rt * 8 + ks) * 64 + lane) * 8);
            const bf16x8 xf = *(const LAS bf16x8*)(XIN + r32 * 272 + (16 * ks + 8 * hi) * 2);
            acc[q] = __builtin_amdgcn_mfma_f32_32x32x16_bf16(af, xf, acc[q], 0, 0, 0); } }
#pragma unroll
    for (int q = 0; q < 4; ++q) { const int rt = w + 8 * q;
#pragma unroll
        for (int rq = 0; rq < 4; ++rq) { const int rowp = 8 * rq + 4 * hi, i = 2 * rt + (rowp >> 4), c0 = rowp & 15;
            u32x2 wv; wv.x = pk2(gelu_tanh(acc[q][4 * rq]), gelu_tanh(acc[q][4 * rq + 1])); wv.y = pk2(gelu_tanh(acc[q][4 * rq + 2]), gelu_tanh(acc[q][4 * rq + 3]));
            *(u32x2*)(Z + ((size_t)(b * SEQ + r32 * 64 + i)) * 256 + g * 16 + c0) = wv; } }
    __syncthreads();
}
typedef short v4i16_t __attribute__((ext_vector_type(4)));
__device__ __forceinline__ s16x4 vtr(const LAS unsigned char* p) { return __builtin_bit_cast(s16x4, __builtin_amdgcn_ds_read_tr16_b64_v4i16((LAS v4i16_t*)p)); }
__device__ __forceinline__ int crow(int r, int hi) { return (r & 3) + 8 * (r >> 2) + 4 * hi; }
constexpr int AT_K = 0, AT_KSLOT = 12288, AT_V = 24576, AT_VSLOT = 8192, AT_WSF = 40960, AT_OST = 43008;
__device__ __forceinline__ void attn_unit(const Frame& F, CArgs& a, int b, int h, int qb) {
    const bf16* Q = (const bf16*)(a.ws + WS_Q); const bf16* K = (const bf16*)(a.ws + WS_K); const bf16* V = (const bf16*)(a.ws + WS_V);
    bf16* Y = (bf16*)(a.ws + WS_Y); float* ssqo = (float*)(a.ws + WS_SMALL + SM_SSQO);
    const int lane = F.lane, w = F.wave, r32 = lane & 31, hi = lane >> 5;
    const int NT = 4 * qb + 4, NTw = 4 * qb + (w >> 1) + 1;
    const size_t rowbase = (size_t)b * SEQ;
    const bf16* Kh = K + rowbase * 768 + h * 96; const bf16* Vh = V + rowbase * 512 + h * 64;
    LAS float* wsf = (LAS float*)(F.lds + AT_WSF) + w * 64;
    bf16x8 qr[6];
    { const bf16* Qw = Q + (rowbase + qb * 256 + w * 32 + r32) * 768 + h * 96 + 8 * hi;
#pragma unroll
      for (int d0 = 0; d0 < 6; ++d0) qr[d0] = *(const bf16x8*)(Qw + 16 * d0); }
    const bf16* ksrc0 = Kh + (size_t)lane * 768 + 8 * w;
    const bf16* ksrc1 = Kh + (size_t)lane * 768 + 8 * (8 + (w & 3));
    const bf16* vsrc = Vh + (size_t)(16 * (w & 3) + (lane >> 2)) * 512 + (w >> 2) * 32 + (lane & 3) * 8;
#define AT_ISSUE(t, s) do { \
        __builtin_amdgcn_global_load_lds((const unsigned*)(ksrc0 + (size_t)(t) * 64 * 768), (LAS unsigned*)(F.lds + AT_K + (s) * AT_KSLOT + w * 1024), 16, 0, 0); \
        if (w < 4) __builtin_amdgcn_global_load_lds((const unsigned*)(ksrc1 + (size_t)(t) * 64 * 768), (LAS unsigned*)(F.lds + AT_K + (s) * AT_KSLOT + (8 + w) * 1024), 16, 0, 0); \
        __builtin_amdgcn_global_load_lds((const unsigned*)(vsrc + (size_t)(t) * 64 * 512), (LAS unsigned*)(F.lds + AT_V + (s) * AT_VSLOT + w * 1024), 16, 0, 0); } while (0)
    float m_run = -1e30f, l_run = 0.f; f32x16 o0 = (f32x16){}, o1 = (f32x16){};
    __syncthreads();
    AT_ISSUE(0, 0);
    asm volatile("s_waitcnt vmcnt(0)" ::: "memory"); __syncthreads();
    for (int t = 0; t < NT; ++t) {
        const int s = t & 1;
        if (t + 1 < NT) AT_ISSUE(t + 1, s ^ 1);
        if (t < NTw) {
            const LAS unsigned char* kb = F.lds + AT_K + s * AT_KSLOT + hi * 1024 + r32 * 16;
            f32x16 p0 = (f32x16){}, p1 = (f32x16){};
#pragma unroll
            for (int d0 = 0; d0 < 6; ++d0) {
                const bf16x8 k0 = *(const LAS bf16x8*)(kb + d0 * 2048), k1 = *(const LAS bf16x8*)(kb + d0 * 2048 + 512);
                p0 = __builtin_amdgcn_mfma_f32_32x32x16_bf16(k0, qr[d0], p0, 0, 0, 0);
                p1 = __builtin_amdgcn_mfma_f32_32x32x16_bf16(k1, qr[d0], p1, 0, 0, 0); }
            float rm = fmaxf(p0[0], p1[0]);
#pragma unroll
            for (int r = 1; r < 16; ++r) rm = fmaxf(rm, fmaxf(p0[r], p1[r]));
            rm = fmaxf(rm, __shfl_xor(rm, 32));
            const float mn = fmaxf(m_run, rm), alpha = __builtin_amdgcn_exp2f(m_run - mn); m_run = mn;
            float sl = 0.f;
#pragma unroll
            for (int r = 0; r < 16; ++r) { p0[r] = __builtin_amdgcn_exp2f(p0[r] - mn); p1[r] = __builtin_amdgcn_exp2f(p1[r] - mn); sl += p0[r] + p1[r]; }
            sl += __shfl_xor(sl, 32);
            l_run = l_run * alpha + sl;
            if (hi == 0) wsf[r32] = alpha;
            bf16x8 pa[4];
#pragma unroll
            for (int ks = 0; ks < 4; ++ks) { u32x4 pw;
#pragma unroll
                for (int e = 0; e < 4; ++e) { const int r = (ks & 1) * 8 + 2 * e; pw[e] = (ks < 2) ? pk2(p0[r], p0[r + 1]) : pk2(p1[r], p1[r + 1]); }
                pa[ks] = __builtin_bit_cast(bf16x8, pw); }
#pragma unroll
            for (int r = 0; r < 16; ++r) { const float f = wsf[crow(r, hi)]; o0[r] *= f; o1[r] *= f; }
            const LAS unsigned char* vb = F.lds + AT_V + s * AT_VSLOT + ((lane >> 4) & 1) * 32 + (lane & 3) * 8 + (4 * hi + ((lane & 15) >> 2)) * 64;
#pragma unroll
            for (int kg = 0; kg < 4; ++kg) {
                const s16x4 l0 = vtr(vb + kg * 1024), h0 = vtr(vb + kg * 1024 + 512), l1 = vtr(vb + 4096 + kg * 1024), h1 = vtr(vb + 4096 + kg * 1024 + 512);
                const bf16x8 v0 = (bf16x8){l0[0], l0[1], l0[2], l0[3], h0[0], h0[1], h0[2], h0[3]}, v1 = (bf16x8){l1[0], l1[1], l1[2], l1[3], h1[0], h1[1], h1[2], h1[3]};
                o0 = __builtin_amdgcn_mfma_f32_32x32x16_bf16(pa[kg], v0, o0, 0, 0, 0);
                o1 = __builtin_amdgcn_mfma_f32_32x32x16_bf16(pa[kg], v1, o1, 0, 0, 0); }
        }
        asm volatile("s_waitcnt vmcnt(0)" ::: "memory"); __syncthreads();
    }
#undef AT_ISSUE
    if (hi == 0) wsf[32 + r32] = l_run;
    LAS bf16* stg = (LAS bf16*)(F.lds + AT_OST) + w * 2048;
#pragma unroll
    for (int r = 0; r < 16; ++r) { const int orow = crow(r, hi); const float rl = 1.0f / wsf[32 + orow];
        stg[orow * 64 + r32] = (bf16)f2bf(o0[r] * rl); stg[orow * 64 + 32 + r32] = (bf16)f2bf(o1[r] * rl); }
    asm volatile("s_waitcnt lgkmcnt(0)" ::: "memory");
#pragma unroll
    for (int i = 0; i < 4; ++i) { const int row = i * 8 + (lane >> 3), ch = lane & 7; const u32x4 v = *(const LAS u32x4*)(stg + row * 64 + ch * 8);
        const size_t tok = rowbase + qb * 256 + w * 32 + row;
        *(u32x4*)(Y + tok * 1024 + h * 64 + ch * 8) = v;
        float q = bflo(v.x) * bflo(v.x) + bfhi(v.x) * bfhi(v.x) + bflo(v.y) * bflo(v.y) + bfhi(v.y) * bfhi(v.y) + bflo(v.z) * bflo(v.z) + bfhi(v.z) * bfhi(v.z) + bflo(v.w) * bflo(v.w) + bfhi(v.w) * bfhi(v.w);
        q += __shfl_xor(q, 1); q += __shfl_xor(q, 2); q += __shfl_xor(q, 4);
        if (ch == 0) ssqo[tok * 8 + h] = q; }
    __syncthreads();
}

constexpr int RT_XS = 0, RT_PART = 33024, RT_LG = RT_PART + 8 * 64 * 37 * 4, RT_SSQ = RT_LG + 64 * 36 * 4, RT_CNT = RT_SSQ + 256, RT_BASE = RT_CNT + 128;
__device__ __forceinline__ void phase_router(const Frame& F, CArgs& a, int l) {
    LAS float* XS = (LAS float*)(F.lds + RT_XS);
    LAS float* PART = (LAS float*)(F.lds + RT_PART);
    LAS float* LG = (LAS float*)(F.lds + RT_LG);
    LAS float* SSQ = (LAS float*)(F.lds + RT_SSQ);
    LAS int* CNT = (LAS int*)(F.lds + RT_CNT); LAS int* BASE = (LAS int*)(F.lds + RT_BASE);
    const float* RT = (const float*)(a.ws + WS_ROUTER) + (size_t)l * 1024 * 40;
    const float* xres = a.out; bf16* XB = (bf16*)(a.ws + WS_XB);
    unsigned* counts = (unsigned*)(a.ws + WS_CTL) + CW_CNT + l * 32;
    int* toklist = (int*)(a.ws + WS_TOKLIST); float* gatelist = (float*)(a.ws + WS_GATELIST); int* tokslot = (int*)(a.ws + WS_SMALL + SM_TOKSLOT);
    float* rstd2 = (float*)(a.ws + WS_SMALL + SM_RSTD2);
    const int w = F.wave, lane = F.lane;
    for (int tile = F.vcu; tile < NTOK / 64; tile += F.G) {
        const int tok0 = tile * 64;
        float acc[37];
#pragma unroll
        for (int j = 0; j < 37; ++j) acc[j] = 0.f;
        __syncthreads();
        if (F.tid < 32) CNT[F.tid] = 0;
        for (int kc = 0; kc < 8; ++kc) {
            __syncthreads();
#pragma unroll
            for (int i = 0; i < 4; ++i) { const int idx = F.tid + 512 * i, row = idx >> 5, c4 = idx & 31;
                const f32x4 v = *(const f32x4*)(xres + (size_t)(tok0 + row) * 1024 + kc * 128 + c4 * 4);
                LAS float* d = XS + row * 129 + c4 * 4; d[0] = v.x; d[1] = v.y; d[2] = v.z; d[3] = v.w;
                u32x2 wv; wv.x = pk2(v.x, v.y); wv.y = pk2(v.z, v.w); *(u32x2*)(XB + (size_t)(tok0 + row) * 1024 + kc * 128 + c4 * 4) = wv; }
            __syncthreads();
            for (int kk = 0; kk < 16; ++kk) { const float x = XS[lane * 129 + 16 * w + kk]; const float* wr_ = RT + (size_t)(kc * 128 + 16 * w + kk) * 40;
#pragma unroll
                for (int j = 0; j < 36; ++j) acc[j] += x * wr_[j];
                acc[36] += x * x; }
        }
#pragma unroll
        for (int j = 0; j < 37; ++j) PART[(w * 64 + lane) * 37 + j] = acc[j];
        __syncthreads();
        { const int tok = F.tid & 63, jg = F.tid >> 6;
            for (int j = jg; j < 37; j += 8) { float s = 0.f;
#pragma unroll
                for (int ww = 0; ww < 8; ++ww) s += PART[(ww * 64 + tok) * 37 + j];
                if (j < 36) LG[tok * 36 + j] = s; else SSQ[tok] = s; } }
        __syncthreads();
        int e_sel[2] = {0, 0}, rank[2] = {0, 0}; float gate[2] = {0.f, 0.f};
        if (F.tid < 64) { const int tok = F.tid; const float rs = 1.0f / sqrtf(SSQ[tok] * (1.0f / 1024.0f) + EPS);
            rstd2[tok0 + tok] = rs;
            float lg[4];
#pragma unroll
            for (int j = 0; j < 4; ++j) lg[j] = rs * LG[tok * 36 + j] + a.b_grp[l * 4 + j];
            int gs = 0; float gm = lg[0];
#pragma unroll
            for (int j = 1; j < 4; ++j) if (lg[j] > gm) { gm = lg[j]; gs = j; }
            float den = 0.f;
#pragma unroll
            for (int j = 0; j < 4; ++j) den += __expf(lg[j] - gm);
            const float pg = 1.0f / den;
            float le[8];
#pragma unroll
            for (int i = 0; i < 8; ++i) le[i] = rs * LG[tok * 36 + 4 + 8 * gs + i] + a.b_exp[l * 32 + 8 * gs + i];
            int i1 = 0; float v1 = le[0];
#pragma unroll
            for (int i = 1; i < 8; ++i) if (le[i] > v1) { v1 = le[i]; i1 = i; }
            int i2 = -1; float v2 = -3.0e38f;
#pragma unroll
            for (int i = 0; i < 8; ++i) if (i != i1 && le[i] > v2) { v2 = le[i]; i2 = i; }
            const float ex = __expf(v2 - v1), p1 = 1.0f / (1.0f + ex), p2 = ex * p1;
            e_sel[0] = 8 * gs + i1; e_sel[1] = 8 * gs + i2; gate[0] = pg * p1; gate[1] = pg * p2;
            rank[0] = __hip_atomic_fetch_add(CNT + e_sel[0], 1, __ATOMIC_RELAXED, __HIP_MEMORY_SCOPE_WORKGROUP);
            rank[1] = __hip_atomic_fetch_add(CNT + e_sel[1], 1, __ATOMIC_RELAXED, __HIP_MEMORY_SCOPE_WORKGROUP); }
        __syncthreads();
        if (F.tid < 32) { const int c = CNT[F.tid]; BASE[F.tid] = c ? (int)__hip_atomic_fetch_add(counts + F.tid, (unsigned)c, __ATOMIC_RELAXED, __HIP_MEMORY_SCOPE_AGENT) : 0; }
        __syncthreads();
        if (F.tid < 64) {
#pragma unroll
            for (int k = 0; k < 2; ++k) { const int e = e_sel[k], slot = BASE[e] + rank[k];
                toklist[e * 16384 + slot] = tok0 + F.tid; gatelist[e * 16384 + slot] = gate[k]; tokslot[(tok0 + F.tid) * 2 + k] = e * 16384 + slot; } }
    }
    __syncthreads();
}

__device__ __forceinline__ void moe_tables(const Frame& F, CArgs& a, int l) {
    LAS int* tab = (LAS int*)(F.lds + MISC_TAB);
    unsigned* counts = (unsigned*)(a.ws + WS_CTL) + CW_CNT + l * 32;
    __syncthreads();
    if (F.tid < 32) tab[F.tid] = (int)__hip_atomic_load(counts + F.tid, __ATOMIC_RELAXED, __HIP_MEMORY_SCOPE_AGENT);
    __syncthreads();
    if (F.tid == 0) { int s = 0; for (int e = 0; e < 32; ++e) { tab[32 + e] = s; s += (tab[e] + 255) >> 8; } tab[64] = s; }
    __syncthreads();
}

__device__ __forceinline__ void phase_combine(const Frame& F, CArgs& a, int l) {
    const LAS int* tab = (const LAS int*)(F.lds + MISC_TAB);
    const int* tokslot = (const int*)(a.ws + WS_SMALL + SM_TOKSLOT); const bf16* YR = (const bf16*)(a.ws + WS_YROWS);
    float* xres = a.out; bf16* XB = (bf16*)(a.ws + WS_XB); float* rstd1 = (float*)(a.ws + WS_SMALL + SM_RSTD1);
    const int gw = F.vcu * 8 + F.wave, NGW = F.G * 8;
    for (int t = gw; t < NTOK; t += NGW) {
        const int s0 = tokslot[t * 2], s1 = tokslot[t * 2 + 1];
        const size_t r0 = (size_t)tab[32 + (s0 >> 14)] * 256 + (s0 & 16383), r1 = (size_t)tab[32 + (s1 >> 14)] * 256 + (s1 & 16383);
        f32x4* xr = (f32x4*)(xres + (size_t)t * 1024) + F.lane; const u32x2* y0 = (const u32x2*)(YR + r0 * 1024) + F.lane; const u32x2* y1 = (const u32x2*)(YR + r1 * 1024) + F.lane;
        float ss = 0.f; f32x4 v[4];
#pragma unroll
        for (int j = 0; j < 4; ++j) { v[j] = xr[64 * j]; const u32x2 p = y0[64 * j], q = y1[64 * j];
            v[j].x = (v[j].x + bflo(p.x)) + bflo(q.x); v[j].y = (v[j].y + bfhi(p.x)) + bfhi(q.x); v[j].z = (v[j].z + bflo(p.y)) + bflo(q.y); v[j].w = (v[j].w + bfhi(p.y)) + bfhi(q.y);
            xr[64 * j] = v[j]; ss += (v[j].x * v[j].x + v[j].y * v[j].y) + (v[j].z * v[j].z + v[j].w * v[j].w); }
        if (l == 0) { ss = wave_sum(ss);
            u32x2* o = (u32x2*)(XB + (size_t)t * 1024) + F.lane;
#pragma unroll
            for (int j = 0; j < 4; ++j) { u32x2 wv; wv.x = pk2(v[j].x, v[j].y); wv.y = pk2(v[j].z, v[j].w); o[64 * j] = wv; }
            if (F.lane == 0) rstd1[t] = 1.0f / sqrtf(ss * (1.0f / 1024.0f) + EPS); }
    }
}
constexpr int NPHASE = 1 + 9 * DEPTH;
#ifndef MK_LAUNCH_PER_PHASE
#define MK_LAUNCH_PER_PHASE 0
#endif
template <int PH> __device__ __forceinline__ void run_phase(const Frame& F_in, int l_in) {
    Frame F; int l = l_in; CArgs* ap = (CArgs*)__builtin_amdgcn_kernarg_segment_ptr();
    { int wv = F_in.wave, ln; asm volatile("v_mbcnt_lo_u32_b32 %0, -1, 0\n\tv_mbcnt_hi_u32_b32 %0, -1, %0" : "=v"(ln)); asm volatile("" : "+s"(wv));
      F.wave = wv; F.lane = ln; F.tid = wv * 64 + ln; F.lds = F_in.lds;
      int G = gridDim.x, bx = blockIdx.x; asm volatile("" : "+s"(G), "+s"(bx), "+s"(l), "+s"(ap)); F.G = G; F.vcu = (G % 8 == 0) ? (bx % 8) * (G / 8) + bx / 8 : bx; }
    CArgs& a = *ap;
    LAS unsigned char* ring = F.lds;
    const LAS float* rs_tab = (const LAS float*)(F.lds + MISC_RS);
    const LAS int* moe_tab = (const LAS int*)(F.lds + MISC_TAB);
    bf16* XB = (bf16*)(a.ws + WS_XB);
    if constexpr (PH == 0) { phase_prologue(F, a); }
    if constexpr (PH == 1) {
        pg8::Gemm g{XB, (const bf16*)(a.ws + WS_WIN) + (size_t)l * 1280 * 1024, 1024};
        pg8::StaticOrder S; S.init(NTOK, 1280, F.G, F.G == 256 ? ((F.vcu & 31) * 8 + (F.vcu >> 5)) : F.vcu);
        epi::EpiInProj E{(const float*)(a.ws + WS_SMALL + SM_RSTD1), (bf16*)(a.ws + WS_CQ), (bf16*)(a.ws + WS_CKV), (bf16*)(a.ws + WS_USSM), (bf16*)(a.ws + WS_CONVA), (bf16*)(a.ws + WS_CONVG),
                         (float*)(a.ws + WS_SMALL + SM_SSQQ), (float*)(a.ws + WS_SMALL + SM_SSQKV), (float*)(a.ws + WS_SMALL + SM_SSQPE)};
        pg8::gemm_phase<epi::EpiInProj, pg8::StaticOrder, true, -1>(ring, g, S, E, rs_tab, F.tid);
    }
    if constexpr (PH == 2) {
        { pg8::Gemm g{(const bf16*)(a.ws + WS_CQ), (const bf16*)(a.ws + WS_WUQ) + (size_t)l * 1024 * 256, 256};
          pg8::StaticOrder S; S.init(NTOK, 1024, F.G, F.G == 256 ? ((F.vcu & 31) * 8 + (F.vcu >> 5)) : F.vcu);
          epi::EpiUp E{(const float*)(a.ws + WS_SMALL + SM_SSQQ), 1.0f / 256.0f, (bf16*)(a.ws + WS_QRAW)};
          pg8::gemm_phase<epi::EpiUp, pg8::StaticOrder, true, -1>(ring, g, S, E, rs_tab, F.tid); }
    }
    if constexpr (PH == 12) {
        { pg8::Gemm g{(const bf16*)(a.ws + WS_CKV), (const bf16*)(a.ws + WS_WUKV) + (size_t)l * 1024 * 256, 256};
          pg8::StaticOrder S; S.init(NTOK, 1024, F.G, F.G == 256 ? ((F.vcu & 31) * 8 + (F.vcu >> 5)) : F.vcu);
          epi::EpiUp E{(const float*)(a.ws + WS_SMALL + SM_SSQKV), 1.0f / 128.0f, (bf16*)(a.ws + WS_KVRAW)};
          pg8::gemm_phase<epi::EpiUp, pg8::StaticOrder, true, -1>(ring, g, S, E, rs_tab, F.tid); }
    }
    if constexpr (PH == 10) {
        for (int u = F.vcu; u < 128; u += F.G) ssm_unit(F, a, l, u);
    }
    if constexpr (PH == 11) {
        for (int u = F.vcu; u < 256; u += F.G) if (u >= 128) { conv_unit(F, a, l, 2 * (u - 128)); conv_unit(F, a, l, 2 * (u - 128) + 1); }
    }
    if constexpr (PH == 3) {
        { pg8::Gemm g{(const bf16*)(a.ws + WS_Z), (const bf16*)(a.ws + WS_WGLU) + (size_t)l * 256 * 256, 256};
          pg8::StaticOrder S; S.init(NTOK, 256, F.G, F.G == 256 ? ((F.vcu & 31) * 8 + (F.vcu >> 5)) : F.vcu);
          epi::EpiGlu E{(const bf16*)(a.ws + WS_Z), (bf16*)(a.ws + WS_Y)};
          pg8::gemm_phase<epi::EpiGlu, pg8::StaticOrder, false, -1>(ring, g, S, E, rs_tab, F.tid); }
        phase_prep(F, a, l);
    }
    if constexpr (PH == 4) {
        for (int v = F.vcu; v < 256; v += F.G) { const int bh = v >> 2, s = v & 3;
            attn_unit(F, a, bh >> 3, bh & 7, s); attn_unit(F, a, bh >> 3, bh & 7, 7 - s); }
    }
    if constexpr (PH == 5) {
        pg8::Gemm g{(const bf16*)(a.ws + WS_Y), (const bf16*)(a.ws + WS_WOUT) + (size_t)l * 1024 * 1024, 1024};
        pg8::StaticOrder S; S.init(NTOK, 1024, F.G, F.G == 256 ? ((F.vcu & 31) * 8 + (F.vcu >> 5)) : F.vcu);
        pg8::Unit u0; const bool has = S.next(0, u0);
        __syncthreads();
        if (has && F.tid < 256) { const float* q = (const float*)(a.ws + WS_SMALL + SM_SSQO) + (size_t)(u0.pm * 256 + F.tid) * 8; float s = 0.f;
#pragma unroll
            for (int hh = 0; hh < 8; ++hh) s += q[hh];
            ((LAS float*)(F.lds + MISC_RS))[F.tid] = 1.0f / sqrtf(s * (1.0f / 512.0f) + EPS); }
        __syncthreads();
        epi::EpiResidual E{l == 0 ? a.x : (const float*)a.out, a.out};
        pg8::gemm_phase<epi::EpiResidual, pg8::StaticOrder, false, 8>(ring, g, S, E, rs_tab, F.tid);
    }
    if constexpr (PH == 6) phase_router(F, a, l);
    if constexpr (PH == 7) {
        moe_tables(F, a, l);
        pg8::Gemm g{XB, (const bf16*)(a.ws + WS_W13) + (size_t)l * NEXP * 1024 * 1024, 1024};
        MoeSched S{moe_tab, (const int*)(a.ws + WS_TOKLIST), F.G, F.vcu, true};
        epi::EpiMoe1 E{moe_tab, (const int*)(a.ws + WS_TOKLIST), (const float*)(a.ws + WS_SMALL + SM_RSTD2), (bf16*)(a.ws + WS_H)};
        pg8::gemm_phase<epi::EpiMoe1, MoeSched, true, -1>(ring, g, S, E, rs_tab, F.tid);
    }
    if constexpr (PH == 8) {
        moe_tables(F, a, l);
        pg8::Gemm g{(const bf16*)(a.ws + WS_H), (const bf16*)(a.ws + WS_W2) + (size_t)l * NEXP * 1024 * 512, 512};
        MoeSched S{moe_tab, (const int*)(a.ws + WS_TOKLIST), F.G, F.vcu, false};
        epi::EpiMoe2 E{moe_tab, (const float*)(a.ws + WS_GATELIST), (bf16*)(a.ws + WS_YROWS)};
        pg8::gemm_phase<epi::EpiMoe2, MoeSched, true, -1>(ring, g, S, E, rs_tab, F.tid);
    }
    if constexpr (PH == 9) { moe_tables(F, a, l); phase_combine(F, a, l); }
}
__device__ __forceinline__ void make_frame(Frame& F, unsigned char* lds_raw) {
    F.lds = (LAS unsigned char*)lds_raw;
    F.tid = threadIdx.x; F.lane = F.tid & 63; F.wave = __builtin_amdgcn_readfirstlane(F.tid >> 6);
    F.G = gridDim.x; { const int bx = blockIdx.x; F.vcu = (F.G % 8 == 0) ? (bx % 8) * (F.G / 8) + bx / 8 : bx; }
}
template <int PH> __global__ void __launch_bounds__(512, 2) k_phase(Args a, int l) {
    extern __shared__ __attribute__((aligned(16))) unsigned char lds_raw[];
    Frame F; make_frame(F, lds_raw);
    run_phase<PH>(F, l);
}
#if !MK_LAUNCH_PER_PHASE
__global__ void __launch_bounds__(512, 2) fwd_kernel(Args a) {
    extern __shared__ __attribute__((aligned(16))) unsigned char lds_raw[];
    Frame F; make_frame(F, lds_raw);
    unsigned* ctl = (unsigned*)(((CArgs*)__builtin_amdgcn_kernarg_segment_ptr())->ws + WS_CTL);
    if (F.tid < 4) ((LAS unsigned*)(F.lds + MISC_BARW))[F.tid] = 0u;
    __syncthreads();
    (void)xcd_barrier_post(ctl + CW_BAR, (volatile LAS unsigned*)(F.lds + MISC_BARW));
#define GRID_SYNC() do { unsigned* bp_ = (unsigned*)(((CArgs*)__builtin_amdgcn_kernarg_segment_ptr())->ws + WS_CTL) + CW_BAR; asm volatile("" : "+s"(bp_)); \
        XcdBarrier b_; b_.bar = bp_; b_.x = xb_xcc_id(); b_.st = (volatile LAS unsigned*)(F.lds + MISC_BARW); xcd_barrier(b_); } while (0)
    run_phase<0>(F, 0); GRID_SYNC();
    for (int l = 0; l < DEPTH; ++l) {
        run_phase<1>(F, l); GRID_SYNC();
        run_phase<2>(F, l); run_phase<12>(F, l); run_phase<10>(F, l); run_phase<11>(F, l); GRID_SYNC();
        run_phase<3>(F, l); GRID_SYNC();
        run_phase<4>(F, l); GRID_SYNC();
        run_phase<5>(F, l); GRID_SYNC();
        run_phase<6>(F, l); GRID_SYNC();
        run_phase<7>(F, l); GRID_SYNC();
        run_phase<8>(F, l); GRID_SYNC();
        run_phase<9>(F, l); if (l + 1 < DEPTH) GRID_SYNC();
    }
}
#endif

extern "C" void kernel_launch(void* const* d_in, const int* in_sizes, int n_in, void* d_out, int out_size, void* d_ws, size_t ws_size, hipStream_t stream) {
    static int grid = 0;
    if (grid == 0) {
        if (n_in != 33 || ws_size < WS_END) { fprintf(stderr, "kernel_launch: unexpected inputs (n_in %d, ws %zu)\n", n_in, ws_size); grid = -1; return; }
#if !MK_LAUNCH_PER_PHASE
        if (hipFuncSetAttribute((const void*)fwd_kernel, hipFuncAttributeMaxDynamicSharedMemorySize, LDS_BYTES) != hipSuccess) { grid = -1; return; }
#else
#define SA(K) if (hipFuncSetAttribute((const void*)K, hipFuncAttributeMaxDynamicSharedMemorySize, LDS_BYTES) != hipSuccess) { fprintf(stderr, "kernel_launch: hipFuncSetAttribute failed\n"); grid = -1; return; }
        SA(k_phase<0>) SA(k_phase<1>) SA(k_phase<2>) SA(k_phase<3>) SA(k_phase<4>) SA(k_phase<5>) SA(k_phase<6>) SA(k_phase<7>) SA(k_phase<8>) SA(k_phase<9>) SA(k_phase<10>) SA(k_phase<11>) SA(k_phase<12>)
#undef SA
#endif
        int per_cu = 0;
#if !MK_LAUNCH_PER_PHASE
        if (hipOccupancyMaxActiveBlocksPerMultiprocessor(&per_cu, (const void*)fwd_kernel, 512, LDS_BYTES) != hipSuccess || per_cu < 1) fprintf(stderr, "kernel_launch: occupancy query reports %d\n", per_cu);
        (void)hipGetLastError();
#endif
        (void)per_cu;
        grid = 256;
    }
    if (grid < 0) return;
    (void)hipMemsetAsync((char*)d_ws + WS_CTL, 0, CTL_ZERO_BYTES, stream);
    Args a{};

    a.x = (const float*)d_in[0]; a.pos = (const int*)d_in[1]; a.mix_norm = (const float*)d_in[2]; a.w_in = (const float*)d_in[3]; a.q_a_norm = (const float*)d_in[4];
    a.w_uq = (const float*)d_in[5]; a.kv_a_norm = (const float*)d_in[6]; a.w_ukv = (const float*)d_in[7]; a.q_norm = (const float*)d_in[8]; a.k_norm = (const float*)d_in[9];
    a.lam_re = (const float*)d_in[10]; a.lam_im = (const float*)d_in[11]; a.b_re = (const float*)d_in[12]; a.b_im = (const float*)d_in[13]; a.c_re = (const float*)d_in[14];
    a.c_im = (const float*)d_in[15]; a.ssm_d = (const float*)d_in[16]; a.log_dt = (const float*)d_in[17]; a.w_glu = (const float*)d_in[18]; a.dw_w = (const float*)d_in[19];
    a.dw_b = (const float*)d_in[20]; a.ln_w = (const float*)d_in[21]; a.ln_b = (const float*)d_in[22]; a.out_norm = (const float*)d_in[23]; a.w_out = (const float*)d_in[24];
    a.ffn_norm = (const float*)d_in[25]; a.w_grp = (const float*)d_in[26]; a.b_grp = (const float*)d_in[27]; a.w_exp = (const float*)d_in[28]; a.b_exp = (const float*)d_in[29];
    a.w1 = (const float*)d_in[30]; a.w3 = (const float*)d_in[31]; a.w2 = (const float*)d_in[32];

    a.out = (float*)d_out; a.ws = (unsigned char*)d_ws;
#if MK_LAUNCH_PER_PHASE
#define LP(PH, l) hipLaunchKernelGGL(k_phase<PH>, dim3(grid), dim3(512), LDS_BYTES, stream, a, l)
    LP(0, 0);
    for (int l = 0; l < DEPTH; ++l) { LP(1, l); LP(2, l); LP(12, l); LP(10, l); LP(11, l); LP(3, l); LP(4, l); LP(5, l); LP(6, l); LP(7, l); LP(8, l); LP(9, l); }
#undef LP
#else
    hipLaunchKernelGGL(fwd_kernel, dim3(grid), dim3(512), LDS_BYTES, stream, a);
#endif
    const hipError_t le = hipPeekAtLastError();
    if (le != hipSuccess) fprintf(stderr, "kernel_launch: launch failed: %s\n", hipGetErrorName(le));
}
```

```cpp
#define MK_LAUNCH_PER_PHASE 0
#include <hip/hip_runtime.h>
#include <cstdio>
#include <cstdint>

#define LAS __attribute__((address_space(3)))
#define GAS __attribute__((address_space(1)))
typedef unsigned short bf16;
typedef short bf16x8 __attribute__((ext_vector_type(8)));
typedef short s16x4 __attribute__((ext_vector_type(4)));
typedef float f32x4 __attribute__((ext_vector_type(4)));
typedef float f32x2 __attribute__((ext_vector_type(2)));
typedef float f32x16 __attribute__((ext_vector_type(16)));
typedef unsigned u32x4 __attribute__((ext_vector_type(4)));
typedef unsigned u32x2 __attribute__((ext_vector_type(2)));

constexpr int DM = 1024, NB = 8, SEQ = 2048, NTOK = NB * SEQ, DEPTH = 2;
constexpr int NH = 8, QK_NOPE = 64, QK_ROPE = 32, QKH = 96, VH = 64, QLORA = 256, KVLORA = 128;
constexpr int SSMW = 256, SSG = 16, SSP = 64, CONVW = 256, CONVK = 31, INPROJ = 1184;
constexpr int NEXP = 32, DFF = 512;
constexpr float EPS = 1e-6f;

constexpr size_t MiB = 1u << 20;
constexpr size_t WS_CTL = 0, CTL_ZERO_BYTES = 1 * MiB;
constexpr size_t WS_ROUTER = 1 * MiB;
constexpr size_t WS_COS = 2 * MiB, WS_SIN = 3 * MiB;
constexpr size_t WS_WIN = 4 * MiB;
constexpr size_t WS_WUQ = 9 * MiB;
constexpr size_t WS_WUKV = 10 * MiB;
constexpr size_t WS_WGLU = 11 * MiB;
constexpr size_t WS_WOUT = 12 * MiB;
constexpr size_t WS_SSMTAB = 16 * MiB;
constexpr size_t SSMTAB_LAYER = 9 * MiB, ST_KD = 0, ST_WST = 512 * 1024, ST_VIN = 512 * 1024 + 4 * MiB, ST_LAM = 512 * 1024 + 8 * MiB;
constexpr size_t WS_W13 = 34 * MiB;
constexpr size_t WS_W2 = 162 * MiB;
constexpr size_t WS_XB = 226 * MiB;
constexpr size_t WS_SMALL = 258 * MiB;
constexpr size_t SM_RSTD1 = 0, SM_RSTD2 = 64 * 1024, SM_SSQQ = 128 * 1024  , SM_SSQKV = 384 * 1024  , SM_SSQPE = 640 * 1024  ,
                 SM_SSQO = 704 * 1024  , SM_TOKSLOT = 1216 * 1024  ;
constexpr size_t WS_CQ = 264 * MiB;
constexpr size_t WS_CKV = 272 * MiB;
constexpr size_t WS_USSM = 280 * MiB;
constexpr size_t WS_CONVA = 288 * MiB, WS_CONVG = 296 * MiB;
constexpr size_t WS_Z = 304 * MiB;
constexpr size_t WS_Y = 312 * MiB;
constexpr size_t WS_TOKLIST = 344 * MiB;
constexpr size_t WS_GATELIST = 346 * MiB;
constexpr size_t WS_QRAW = 348 * MiB;
constexpr size_t WS_KVRAW = 380 * MiB;
constexpr size_t WS_Q = 412 * MiB;
constexpr size_t WS_K = 436 * MiB;
constexpr size_t WS_V = 460 * MiB;
constexpr size_t WS_END = 476 * MiB;
constexpr size_t WS_H = 348 * MiB;
constexpr size_t WS_YROWS = 388 * MiB;
constexpr int MAXROWS = 40960;
constexpr int CW_BAR = 4096;
constexpr int CW_CNT = 8192;

constexpr int RING_BYTES = 131072;
constexpr int MISC_OFF = RING_BYTES;
constexpr int MISC_BARW = MISC_OFF;
constexpr int MISC_TAB = MISC_OFF + 64;
constexpr int MISC_RS = MISC_OFF + 1024;
constexpr int LDS_BYTES = 147456;

__device__ __forceinline__ unsigned f2bf(float f) { unsigned u = __builtin_bit_cast(unsigned, f); return (u + 0x7fffu + ((u >> 16) & 1u)) >> 16; }
__device__ __forceinline__ unsigned pk2(float lo, float hi) { return f2bf(lo) | (f2bf(hi) << 16); }
__device__ __forceinline__ float bf2f(unsigned short b) { return __builtin_bit_cast(float, (unsigned)b << 16); }
__device__ __forceinline__ float bflo(unsigned w) { return __builtin_bit_cast(float, w << 16); }
__device__ __forceinline__ float bfhi(unsigned w) { return __builtin_bit_cast(float, w & 0xffff0000u); }
__device__ __forceinline__ float wave_sum(float v) {
#pragma unroll
    for (int o = 1; o < 64; o <<= 1) v += __shfl_xor(v, o);
    return v;
}
__device__ __forceinline__ float sigmoidf_(float x) { return 1.0f / (1.0f + __expf(-x)); }
__device__ __forceinline__ float gelu_tanh(float y) { const float a = 0.7978845608028654f * (y + 0.044715f * y * y * y); const float t = 1.0f - 2.0f / (__expf(2.0f * a) + 1.0f); return 0.5f * y * (1.0f + t); }

namespace pg8 {
constexpr int BM = 256, BK = 64, HALF = 128, HTB = HALF * BK * 2, STAGE_BYTES = 8 * HTB, NXCD = 8, WGM = 8;
__host__ __device__ __forceinline__ int lds_byte(int r, int c) { const int st = (r >> 4) * 2 + (c >> 5), rr = r & 15, cc = c & 31, ob = rr * 64 + cc * 2; return st * 1024 + (ob ^ (((ob >> 9) & 1) << 5)); }
__host__ __device__ __forceinline__ void stage_rc(int b, int& R, int& C) { const int st = b / 1024, sb = b % 1024, swz = sb ^ (((sb >> 9) & 1) << 5); R = (st >> 1) * 16 + swz / 64; C = (st & 1) * 32 + (swz % 64) / 2; }
__host__ __device__ __forceinline__ int perm32(int rho) { const int n = rho >> 4, i = rho & 15; return 8 * (i >> 2) + 4 * n + (i & 3); }

struct Unit { int pm, pn; };
struct Gemm { const bf16* A; const bf16* Bt; int K; };

struct StaticOrder {
    int nM, nN, nwg, G, c;
    __device__ void init(int M, int N, int G_, int c_) { nM = M / BM; nN = N / BM; nwg = nM * nN; G = G_; c = c_; }
    __device__ bool next(int i, Unit& u) const {
        const long L = (long)i * G + c; if (L >= nwg) return false;
        int wgid = (int)L; { const int q = nwg / NXCD, r = nwg % NXCD, xcd = wgid % NXCD, off = wgid / NXCD; wgid = (xcd < r ? xcd * (q + 1) : r * (q + 1) + (xcd - r) * q) + off; }
        const int nig = WGM * nN, gid = wgid / nig, fm = gid * WGM, gsz = (nM - fm) < WGM ? (nM - fm) : WGM;
        u.pm = fm + ((wgid % nig) % gsz); u.pn = (wgid % nig) / gsz; return true;
    }
    __device__ __forceinline__ unsigned arow(const Unit& u, int rloc) const { return (unsigned)(u.pm * BM + rloc); }
};

template <class Epi, class Sched, bool ALIGN_EPI, int KSCALE_T>
__device__ __forceinline__ void gemm_phase(LAS unsigned char* lds, const Gemm g, const Sched& S, const Epi& E, const LAS float* rs, const int tid) {
    const int wid = __builtin_amdgcn_readfirstlane(tid >> 6), lane = tid & 63, wr = wid >> 2, wc = wid & 3, fr = lane & 15, fq = lane >> 4;
    const int K = g.K, nt = K / BK;
    int Rst[2]; unsigned cofs[2]; unsigned voffB[2];
#pragma unroll
    for (int i = 0; i < 2; ++i) { int R, C; stage_rc(tid * 16 + i * 8192, R, C); const int Rb = Epi::PERM ? ((R & ~31) + perm32(R & 31)) : R;
        Rst[i] = R; cofs[i] = (unsigned)C * 2u; voffB[i] = (unsigned)(Rb * K + C) * 2u; }
    const size_t kstep = (size_t)(BK * 2);
    const size_t hstepB = (size_t)HALF * K * 2;
    const size_t tstepB = 2 * hstepB;
    const unsigned ldsw = (unsigned)wid * 1024u;
    const int aoff = lds_byte(wr * 64 + fr, fq * 8), boff = lds_byte(wc * 32 + fr, fq * 8);
#define PG8_SA(b, h) (((b) * 2 + (h)) * HTB)
#define PG8_SB(b, h) ((4 + (b) * 2 + (h)) * HTB)
#define PG8_STAGEB(bufoff, gbase) do { _Pragma("unroll") for (int _i = 0; _i < 2; ++_i) \
        __builtin_amdgcn_global_load_lds((const unsigned*)((const char*)(gbase) + voffB[_i]), (LAS unsigned*)(lds + (bufoff) + ldsw + _i * 8192), 16, 0, 0); } while (0)
#define PG8_STAGEA(bufoff, gbase, vo, h) do { _Pragma("unroll") for (int _i = 0; _i < 2; ++_i) \
        __builtin_amdgcn_global_load_lds((const unsigned*)((const char*)(gbase) + (vo)[h][_i]), (LAS unsigned*)(lds + (bufoff) + ldsw + _i * 8192), 16, 0, 0); } while (0)
#define PG8_LDA(dst, b, h) do { _Pragma("unroll") for (int m = 0; m < 4; ++m) _Pragma("unroll") for (int k = 0; k < 2; ++k) dst[m][k] = *(const LAS bf16x8*)(lds + PG8_SA(b, h) + aoff + m * 2048 + k * 1024); } while (0)
#define PG8_LDB(dst, b, h) do { _Pragma("unroll") for (int n = 0; n < 2; ++n) _Pragma("unroll") for (int k = 0; k < 2; ++k) dst[n][k] = *(const LAS bf16x8*)(lds + PG8_SB(b, h) + boff + n * 2048 + k * 1024); } while (0)
#define PG8_MMA(ai, bj, At, Bt) do { __builtin_amdgcn_s_setprio(1); _Pragma("unroll") for (int m = 0; m < 4; ++m) _Pragma("unroll") for (int n = 0; n < 2; ++n) _Pragma("unroll") for (int k = 0; k < 2; ++k) \
        acc[ai][bj][m][n] = __builtin_amdgcn_mfma_f32_16x16x32_bf16(Bt[n][k], At[m][k], acc[ai][bj][m][n], 0, 0, 0); __builtin_amdgcn_s_setprio(0); } while (0)
#define PG8_WAIT_V(n) asm volatile("s_waitcnt vmcnt(" #n ")" ::: "memory")
#define PG8_WAIT_L(n) asm volatile("s_waitcnt lgkmcnt(" #n ")" ::: "memory")
#define PG8_BAR __builtin_amdgcn_s_barrier()
#define PG8_SCHED __builtin_amdgcn_sched_barrier(0)
#define PG8_AOFFS(vo, u) do { _Pragma("unroll") for (int _h = 0; _h < 2; ++_h) _Pragma("unroll") for (int _i = 0; _i < 2; ++_i) \
        (vo)[_h][_i] = S.arow((u), _h * HALF + Rst[_i]) * (unsigned)(K * 2) + cofs[_i]; } while (0)
    Unit cur, nxt; int ui = 0;
    if (!S.next(0, cur)) return;
    f32x4 acc[2][2][4][2];
#pragma unroll
    for (int a = 0; a < 2; ++a)
#pragma unroll
        for (int b = 0; b < 2; ++b)
#pragma unroll
            for (int m = 0; m < 4; ++m)
#pragma unroll
                for (int n = 0; n < 2; ++n) acc[a][b][m][n] = (f32x4){0.f, 0.f, 0.f, 0.f};
    bf16x8 At[4][2], B0[2][2], B1[2][2];
    unsigned voC[2][2], voN[2][2];
    PG8_AOFFS(voC, cur);
    const char* gA = (const char*)g.A;
    const char* cB = (const char*)g.Bt + (size_t)cur.pn * tstepB;
    PG8_STAGEB(PG8_SB(0, 0), cB); PG8_STAGEB(PG8_SB(0, 1), cB + hstepB); PG8_STAGEA(PG8_SA(0, 0), gA, voC, 0); PG8_STAGEA(PG8_SA(0, 1), gA, voC, 1);
    if (wr == 1) PG8_BAR;
    PG8_WAIT_V(2); PG8_BAR;
    PG8_STAGEB(PG8_SB(1, 0), cB + kstep); PG8_STAGEA(PG8_SA(1, 0), gA + kstep, voC, 0); PG8_STAGEB(PG8_SB(1, 1), cB + hstepB + kstep);
    PG8_WAIT_V(6); PG8_BAR;
    for (;;) {
        const bool has_next = S.next(ui + 1, nxt);
        if (has_next) { PG8_AOFFS(voN, nxt); } else {
#pragma unroll
            for (int _h = 0; _h < 2; ++_h)
#pragma unroll
                for (int _i = 0; _i < 2; ++_i) voN[_h][_i] = voC[_h][_i]; }
        const char* nB = has_next ? (const char*)g.Bt + (size_t)nxt.pn * tstepB : cB;
#pragma nounroll
        for (int t = 0; t < nt; t += 2) {
            const bool last = (t == nt - 2);
            if (KSCALE_T >= 0 && t == KSCALE_T) {
#pragma unroll
                for (int ai = 0; ai < 2; ++ai)
#pragma unroll
                    for (int m = 0; m < 4; ++m) { const float sc = rs[ai * HALF + wr * 64 + m * 16 + fr];
#pragma unroll
                        for (int bj = 0; bj < 2; ++bj)
#pragma unroll
                            for (int n = 0; n < 2; ++n) acc[ai][bj][m][n] *= sc; }
            }
            const char* a1 = gA + (size_t)(t + 1) * kstep;
            const char* a2 = last ? gA : gA + (size_t)(t + 2) * kstep; const char* b2 = last ? nB : cB + (size_t)(t + 2) * kstep;
            const char* a3 = a2 + kstep; const char* b3 = b2 + kstep;
            unsigned vo2[2][2];
#pragma unroll
            for (int _h = 0; _h < 2; ++_h)
#pragma unroll
                for (int _i = 0; _i < 2; ++_i) vo2[_h][_i] = last ? voN[_h][_i] : voC[_h][_i];
            PG8_LDB(B0, 0, 0); PG8_LDB(B1, 0, 1); PG8_SCHED; PG8_LDA(At, 0, 0); PG8_STAGEA(PG8_SA(1, 1), a1, voC, 1);
            PG8_WAIT_V(8); PG8_WAIT_L(0); PG8_BAR; PG8_MMA(0, 0, At, B0); PG8_MMA(0, 1, At, B1); PG8_BAR; PG8_SCHED;
            PG8_LDA(At, 0, 1); PG8_STAGEB(PG8_SB(0, 0), b2); PG8_STAGEB(PG8_SB(0, 1), b2 + hstepB); PG8_STAGEA(PG8_SA(0, 0), a2, vo2, 0);
            PG8_WAIT_V(8); PG8_WAIT_L(0); PG8_BAR; PG8_MMA(1, 0, At, B0); PG8_MMA(1, 1, At, B1); PG8_BAR; PG8_SCHED;
            PG8_LDB(B0, 1, 0); PG8_LDB(B1, 1, 1); PG8_SCHED; PG8_LDA(At, 1, 0); PG8_STAGEA(PG8_SA(0, 1), a2, vo2, 1);
            PG8_WAIT_V(8); PG8_WAIT_L(0); PG8_BAR; PG8_MMA(0, 0, At, B0); PG8_MMA(0, 1, At, B1); PG8_BAR; PG8_SCHED;
            PG8_LDA(At, 1, 1); PG8_STAGEB(PG8_SB(1, 0), b3); PG8_STAGEB(PG8_SB(1, 1), b3 + hstepB); PG8_STAGEA(PG8_SA(1, 0), a3, vo2, 0);
            PG8_WAIT_V(8); PG8_WAIT_L(0); PG8_BAR; PG8_MMA(1, 0, At, B0); PG8_MMA(1, 1, At, B1); PG8_BAR; PG8_SCHED;
        }
        if constexpr (ALIGN_EPI) { if (wr == 0) PG8_BAR; }
        if constexpr (!Epi::AFTER_DRAIN) { E(acc, cur, wr, wc, fr, fq); }
        if (!has_next) break;
#pragma unroll
        for (int a = 0; a < 2; ++a)
#pragma unroll
            for (int b = 0; b < 2; ++b)
#pragma unroll
                for (int m = 0; m < 4; ++m)
#pragma unroll
                    for (int n = 0; n < 2; ++n) acc[a][b][m][n] = (f32x4){0.f, 0.f, 0.f, 0.f};
        cur = nxt; cB = nB; ++ui;
#pragma unroll
        for (int _h = 0; _h < 2; ++_h)
#pragma unroll
            for (int _i = 0; _i < 2; ++_i) voC[_h][_i] = voN[_h][_i];
        if constexpr (ALIGN_EPI) { if (wr == 1) PG8_BAR; }
    }
    PG8_WAIT_V(0);
    if constexpr (!ALIGN_EPI) { if (wr == 0) PG8_BAR; }
    PG8_BAR;
    if constexpr (Epi::AFTER_DRAIN) { E.fused(acc, cur, wr, wc, fr, fq, lds, wid, lane); }
#undef PG8_SA
#undef PG8_SB
#undef PG8_STAGEA
#undef PG8_STAGEB
#undef PG8_LDA
#undef PG8_LDB
#undef PG8_MMA
#undef PG8_WAIT_V
#undef PG8_WAIT_L
#undef PG8_BAR
#undef PG8_SCHED
#undef PG8_AOFFS
}
}
namespace epi {
using pg8::Unit; using pg8::BM; using pg8::HALF;
__device__ __forceinline__ unsigned cvt_pk_bf16(float lo, float hi) { unsigned r; asm volatile("v_cvt_pk_bf16_f32 %0, %1, %2" : "=v"(r) : "v"(lo), "v"(hi)); return r; }
__device__ __forceinline__ u32x4 pack8(const f32x4 a, const f32x4 b) { u32x4 w; w.x = cvt_pk_bf16(a[0], a[1]); w.y = cvt_pk_bf16(a[2], a[3]); w.z = cvt_pk_bf16(b[0], b[1]); w.w = cvt_pk_bf16(b[2], b[3]); return w; }

struct EpiInProj {
    static constexpr bool PERM = true, AFTER_DRAIN = false;
    const float* rstd1; bf16* cq; bf16* ckv; bf16* ussm; bf16* conva; bf16* convg; float* ssqq; float* ssqkv; float* ssqpe;
    __device__ __forceinline__ void operator()(const f32x4 (&acc)[2][2][4][2], const Unit& u, int wr, int wc, int fr, int fq) const {
        const int cl0 = wc * 32 + 8 * fq;
#pragma unroll
        for (int ai = 0; ai < 2; ++ai)
#pragma unroll
            for (int m = 0; m < 4; ++m) {
                const int row = u.pm * BM + ai * HALF + wr * 64 + m * 16 + fr;
                const float rs = rstd1[row];
                f32x4 v[2][2];
#pragma unroll
                for (int bj = 0; bj < 2; ++bj)
#pragma unroll
                    for (int n = 0; n < 2; ++n) v[bj][n] = acc[ai][bj][m][n] * rs;
                if (u.pn == 0 || u.pn == 1) {
                    bf16* dst = (u.pn == 0) ? cq : ckv;
                    float s0 = 0.f, s1 = 0.f;
#pragma unroll
                    for (int n = 0; n < 2; ++n)
#pragma unroll
                        for (int i = 0; i < 4; ++i) { s0 += v[0][n][i] * v[0][n][i]; s1 += v[1][n][i] * v[1][n][i]; }
                    s0 += __shfl_xor(s0, 16); s0 += __shfl_xor(s0, 32); s1 += __shfl_xor(s1, 16); s1 += __shfl_xor(s1, 32);
#pragma unroll
                    for (int bj = 0; bj < 2; ++bj) *(u32x4*)(dst + (size_t)row * 256 + bj * HALF + cl0) = pack8(v[bj][0], v[bj][1]);
                    if (fq == 0) {
                        if (u.pn == 0) ssqq[row * 4 + wc] = s0 + s1;
                        else { ssqkv[row * 4 + wc] = s0; if (wc == 0) ssqpe[row] = s1; }
                    }
                } else if (u.pn == 2) {
                    const int b = row >> 11, t = row & 2047, nch = t >> 6, j = t & 63;
#pragma unroll
                    for (int bj = 0; bj < 2; ++bj) { const int c = bj * HALF + cl0, gg = c >> 4, c0 = c & 15;
                        *(u32x4*)(ussm + ((((size_t)(b * 16 + gg) * 64 + j) * 32 + nch) * 16 + c0)) = pack8(v[bj][0], v[bj][1]); }
                } else {
                    bf16* dst = (u.pn == 3) ? conva : convg;
#pragma unroll
                    for (int bj = 0; bj < 2; ++bj) *(u32x4*)(dst + (size_t)row * 256 + bj * HALF + cl0) = pack8(v[bj][0], v[bj][1]);
                }
            }
    }
};

struct EpiUp {
    static constexpr bool PERM = true, AFTER_DRAIN = false;
    const float* ssq4; float inv_width; bf16* out;
    __device__ __forceinline__ void operator()(const f32x4 (&acc)[2][2][4][2], const Unit& u, int wr, int wc, int fr, int fq) const {
        const int col0 = u.pn * BM + wc * 32 + 8 * fq;
#pragma unroll
        for (int ai = 0; ai < 2; ++ai)
#pragma unroll
            for (int m = 0; m < 4; ++m) {
                const int row = u.pm * BM + ai * HALF + wr * 64 + m * 16 + fr;
                const f32x4 q = *(const f32x4*)(ssq4 + row * 4);
                const float rs = 1.0f / sqrtf(((q[0] + q[1]) + (q[2] + q[3])) * inv_width + EPS);
#pragma unroll
                for (int bj = 0; bj < 2; ++bj) *(u32x4*)(out + (size_t)row * 1024 + col0 + bj * HALF) = pack8(acc[ai][bj][m][0] * rs, acc[ai][bj][m][1] * rs);
            }
    }
};

struct EpiGlu {
    static constexpr bool PERM = true, AFTER_DRAIN = true;
    const bf16* z; bf16* y;
    __device__ __forceinline__ void fused(f32x4 (&acc)[2][2][4][2], const Unit& u, int wr, int wc, int fr, int fq, LAS unsigned char* lds, int wid, int lane) const {
        LAS float* P = (LAS float*)lds;
        const int col0 = wc * 32 + 8 * fq;
#pragma unroll
        for (int ai = 0; ai < 2; ++ai)
#pragma unroll
            for (int m = 0; m < 4; ++m) {
                const int rl = ai * HALF + wr * 64 + m * 16 + fr, row = u.pm * BM + rl;
                float s = 0.f;
#pragma unroll
                for (int bj = 0; bj < 2; ++bj) {
                    const u32x4 zw = *(const u32x4*)(z + (size_t)row * 256 + bj * HALF + col0);
                    const float zf[8] = {bflo(zw.x), bfhi(zw.x), bflo(zw.y), bfhi(zw.y), bflo(zw.z), bfhi(zw.z), bflo(zw.w), bfhi(zw.w)};
#pragma unroll
                    for (int n = 0; n < 2; ++n)
#pragma unroll
                        for (int i = 0; i < 4; ++i) { const float o = zf[n * 4 + i] * sigmoidf_(acc[ai][bj][m][n][i]); acc[ai][bj][m][n][i] = o; s += o * o; }
                }
                s += __shfl_xor(s, 16); s += __shfl_xor(s, 32);
                if (fq == 0) P[rl * 4 + wc] = s;
            }
        asm volatile("s_waitcnt lgkmcnt(0)" ::: "memory"); __builtin_amdgcn_s_barrier(); asm volatile("" ::: "memory");
#pragma unroll
        for (int ai = 0; ai < 2; ++ai)
#pragma unroll
            for (int m = 0; m < 4; ++m) {
                const int rl = ai * HALF + wr * 64 + m * 16 + fr, row = u.pm * BM + rl;
                const f32x4 q = *(const LAS f32x4*)(P + rl * 4);
                const float rs = 1.0f / sqrtf(((q[0] + q[1]) + (q[2] + q[3])) * (1.0f / 256.0f) + EPS);
#pragma unroll
                for (int bj = 0; bj < 2; ++bj) *(u32x4*)(y + (size_t)row * 1024 + 512 + bj * HALF + col0) = pack8(acc[ai][bj][m][0] * rs, acc[ai][bj][m][1] * rs);
            }
        asm volatile("s_waitcnt lgkmcnt(0)" ::: "memory"); __builtin_amdgcn_s_barrier(); asm volatile("" ::: "memory");
    }
};

struct EpiResidual {
    static constexpr bool PERM = false, AFTER_DRAIN = false;
    const float* xin; float* xout;
    __device__ __forceinline__ void operator()(const f32x4 (&acc)[2][2][4][2], const Unit& u, int wr, int wc, int fr, int fq) const {
        const int col0 = u.pn * BM + wc * 32 + 4 * fq;
#pragma unroll
        for (int ai = 0; ai < 2; ++ai)
#pragma unroll
            for (int m = 0; m < 4; ++m) {
                const size_t off = (size_t)(u.pm * BM + ai * HALF + wr * 64 + m * 16 + fr) * 1024 + col0;
#pragma unroll
                for (int bj = 0; bj < 2; ++bj)
#pragma unroll
                    for (int n = 0; n < 2; ++n) { const f32x4 b = *(const f32x4*)(xin + off + bj * HALF + n * 16); *(f32x4*)(xout + off + bj * HALF + n * 16) = b + acc[ai][bj][m][n]; }
            }
    }
};
}

struct MoeSched {
    const LAS int* tab; const int* toklist; int G, c; bool gather;
    __device__ __forceinline__ int expert_of(int pmb) const { int e = 0;
        for (int k = 1; k < 32; ++k) e += (tab[32 + k] <= pmb) ? 1 : 0;
        return e; }
    __device__ bool next(int i, pg8::Unit& u) const {
        const int idx = i * G + c, nunits = tab[64] * 4; if (idx >= nunits) return false;
        const int pmb = idx >> 2, j = idx & 3; const int e = expert_of(pmb);
        u.pm = pmb; u.pn = e * 4 + j; return true;
    }
    __device__ __forceinline__ unsigned arow(const pg8::Unit& u, int rloc) const {
        if (!gather) return (unsigned)(u.pm * 256 + rloc);
        const int e = u.pn >> 2; const int s = (u.pm - tab[32 + e]) * 256 + rloc;
        return (s < tab[e]) ? (unsigned)toklist[e * 16384 + s] : 0u;
    }
};
namespace epi {
struct EpiMoe1 {
    static constexpr bool PERM = true, AFTER_DRAIN = false;
    const LAS int* tab; const int* toklist; const float* rstd2; bf16* H;
    __device__ __forceinline__ void operator()(const f32x4 (&acc)[2][2][4][2], const Unit& u, int wr, int wc, int fr, int fq) const {
        const int e = u.pn >> 2, j = u.pn & 3, cnt = tab[e], s0 = (u.pm - tab[32 + e]) * 256;
#pragma unroll
        for (int ai = 0; ai < 2; ++ai)
#pragma unroll
            for (int m = 0; m < 4; ++m) {
                const int rl = ai * HALF + wr * 64 + m * 16 + fr, s = s0 + rl;
                float rs = 0.f; if (s < cnt) rs = rstd2[toklist[e * 16384 + s]];
                f32x4 o[2];
#pragma unroll
                for (int n = 0; n < 2; ++n)
#pragma unroll
                    for (int i = 0; i < 4; ++i) { const float a = acc[ai][0][m][n][i] * rs, b = acc[ai][1][m][n][i] * rs; o[n][i] = a * sigmoidf_(a) * b; }
                *(u32x4*)(H + (size_t)(u.pm * 256 + rl) * 512 + j * 128 + wc * 32 + 8 * fq) = pack8(o[0], o[1]);
            }
    }
};
struct EpiMoe2 {
    static constexpr bool PERM = true, AFTER_DRAIN = false;
    const LAS int* tab; const float* gatelist; bf16* Y;
    __device__ __forceinline__ void operator()(const f32x4 (&acc)[2][2][4][2], const Unit& u, int wr, int wc, int fr, int fq) const {
        const int e = u.pn >> 2, j = u.pn & 3, cnt = tab[e], s0 = (u.pm - tab[32 + e]) * 256;
        const int col0 = j * 256 + wc * 32 + 8 * fq;
#pragma unroll
        for (int ai = 0; ai < 2; ++ai)
#pragma unroll
            for (int m = 0; m < 4; ++m) {
                const int rl = ai * HALF + wr * 64 + m * 16 + fr, s = s0 + rl;
                float gt = 0.f; if (s < cnt) gt = gatelist[e * 16384 + s];
#pragma unroll
                for (int bj = 0; bj < 2; ++bj) *(u32x4*)(Y + (size_t)(u.pm * 256 + rl) * 1024 + col0 + bj * HALF) = pack8(acc[ai][bj][m][0] * gt, acc[ai][bj][m][1] * gt);
            }
    }
};
}
#define XB_TMO      128
#define XB_XCNT(j)  (256  + 64 * (j))
#define XB_XSUB(j)  (1280 + 64 * (j))
#define XB_XGEN(j)  (2304 + 64 * (j))
#define XB_TOP      3328
#define XB_TOPGEN   3392
#define XCD_BAR_WORDS 3456
#define XB_SPIN_CAP (1u << 18)
__device__ __forceinline__ unsigned xb_ld(unsigned* p)              { return __hip_atomic_load(p, __ATOMIC_RELAXED, __HIP_MEMORY_SCOPE_AGENT); }
__device__ __forceinline__ unsigned xb_add(unsigned* p, unsigned v) { return __hip_atomic_fetch_add(p, v, __ATOMIC_RELAXED, __HIP_MEMORY_SCOPE_AGENT); }
__device__ __forceinline__ unsigned xb_xcc_id() { return (unsigned)__builtin_amdgcn_s_getreg((3 << 11) | 20) & 0xFu; }
#define XB_SPIN(cond, bar) do { unsigned _sp = 0; while (cond) { __builtin_amdgcn_s_sleep(1); \
    if ((++_sp & 255u) == 0u) { if (xb_ld(&(bar)[XB_TMO])) break; if (_sp > XB_SPIN_CAP) { atomicAdd(&(bar)[XB_TMO], 1u); break; } } } } while (0)
struct XcdBarrier { unsigned* bar; unsigned x; volatile LAS unsigned* st; };
__device__ __forceinline__ XcdBarrier xcd_barrier_post(unsigned* bar, volatile LAS unsigned* st) {
    XcdBarrier b; b.bar = bar; b.x = xb_xcc_id(); b.st = st;
    if (threadIdx.x == 0) (void)xb_add(&bar[XB_XCNT(b.x)], 1u);
    return b;
}
__device__ __forceinline__ void xcd_barrier_complete(unsigned* bar, unsigned x, unsigned& nloc, unsigned& nx) {
    const unsigned G = gridDim.x * gridDim.y * gridDim.z;
    unsigned sum, cnt, mine, sp = 0u;
    for (;;) {
        sum = 0u; cnt = 0u; mine = 0u;
#pragma unroll
        for (unsigned j = 0; j < 16; ++j) { const unsigned c = xb_ld(&bar[XB_XCNT(j)]); sum += c; cnt += (c > 0u) ? 1u : 0u; mine = (j == x) ? c : mine; }
        if (sum == G) break;
        __builtin_amdgcn_s_sleep(1);
        if ((++sp & 255u) == 0u) { if (xb_ld(&bar[XB_TMO])) break; if (sp > XB_SPIN_CAP) { atomicAdd(&bar[XB_TMO], 1u); break; } }
    }
    nloc = mine > 0u ? mine : 1u; nx = cnt > 0u ? cnt : 1u;
}
__device__ __forceinline__ void xcd_barrier(const XcdBarrier& b) {
    asm volatile("s_waitcnt vmcnt(0)" ::: "memory");
    __syncthreads();
    if (threadIdx.x == 0) {
        unsigned* bar = b.bar;
        __builtin_amdgcn_s_waitcnt(0);
        unsigned nloc = b.st[0], nx = b.st[1];
        if (nloc == 0u) { xcd_barrier_complete(bar, b.x, nloc, nx); b.st[0] = nloc; b.st[1] = nx; }
        const unsigned old = xb_add(&bar[XB_XSUB(b.x)], 1u);
        const unsigned gen = old / nloc;
        if (old + 1u == (gen + 1u) * nloc) {
            __builtin_amdgcn_fence(__ATOMIC_RELEASE, "agent");
            asm volatile("s_waitcnt vmcnt(0)" ::: "memory");
            const unsigned og = xb_add(&bar[XB_TOP], 1u);
            const unsigned tg = og / nx;
            if (og + 1u == (tg + 1u) * nx) xb_add(&bar[XB_TOPGEN], 1u);
            else XB_SPIN(xb_ld(&bar[XB_TOPGEN]) == tg, bar);
            __builtin_amdgcn_fence(__ATOMIC_ACQUIRE, "agent");
            xb_add(&bar[XB_XGEN(b.x)], 1u);
            asm volatile("s_waitcnt vmcnt(0)" ::: "memory");
        } else {
            XB_SPIN(xb_ld(&bar[XB_XGEN(b.x)]) == gen, bar);
            __builtin_amdgcn_fence(__ATOMIC_ACQUIRE, "agent");
            asm volatile("s_waitcnt vmcnt(0)" ::: "memory");
        }
    }
    __syncthreads();
}

struct Args {
    const float* x; const int* pos; const float* mix_norm; const float* w_in; const float* q_a_norm; const float* w_uq; const float* kv_a_norm; const float* w_ukv;
    const float* q_norm; const float* k_norm; const float* lam_re; const float* lam_im; const float* b_re; const float* b_im; const float* c_re; const float* c_im;
    const float* ssm_d; const float* log_dt; const float* w_glu; const float* dw_w; const float* dw_b; const float* ln_w; const float* ln_b; const float* out_norm;
    const float* w_out; const float* ffn_norm; const float* w_grp; const float* b_grp; const float* w_exp; const float* b_exp; const float* w1; const float* w3; const float* w2;
    float* out; unsigned char* ws;
};
typedef const Args __attribute__((address_space(4))) CArgs;
struct Frame {
    LAS unsigned char* lds; int tid, lane, wave, vcu, G;
};

struct TItem { const float* W; const float* gain; bf16* WT; int ldw, k0, n0, dpitch, dst_row0; };
__device__ __forceinline__ void titem_load(const TItem& t, f32x4 (&v)[8], float (&g)[8], int lane) {
#pragma unroll
    for (int i = 0; i < 8; ++i) { const int kk = i * 8 + (lane >> 3); v[i] = *(const f32x4*)(t.W + (size_t)(t.k0 + kk) * t.ldw + t.n0 + (lane & 7) * 4); g[i] = t.gain ? t.gain[t.k0 + kk] : 1.0f; }
}
__device__ __forceinline__ void titem_store(const TItem& t, const f32x4 (&v)[8], const float (&g)[8], LAS float* scr, int lane) {
#pragma unroll
    for (int i = 0; i < 8; ++i) { const int kk = i * 8 + (lane >> 3); LAS float* d = scr + kk * 33 + (lane & 7) * 4; d[0] = v[i].x * g[i]; d[1] = v[i].y * g[i]; d[2] = v[i].z * g[i]; d[3] = v[i].w * g[i]; }
    asm volatile("s_waitcnt lgkmcnt(0)" ::: "memory");
    const int c = lane & 7;
#pragma unroll
    for (int j = 0; j < 4; ++j) { const int n = (lane >> 3) + 8 * j; const LAS float* s = scr + (8 * c) * 33 + n;
        u32x4 o; o.x = pk2(s[0 * 33], s[1 * 33]); o.y = pk2(s[2 * 33], s[3 * 33]); o.z = pk2(s[4 * 33], s[5 * 33]); o.w = pk2(s[6 * 33], s[7 * 33]);
        *(u32x4*)(t.WT + (size_t)(t.dst_row0 + n) * t.dpitch + t.k0 + 8 * c) = o; }
    asm volatile("s_waitcnt lgkmcnt(0)" ::: "memory");
}

__device__ __forceinline__ void sincos_d(double x, double& s, double& c) {
    const double q = rint(x * 0.63661977236758134308); const int iq = (int)q;
    double r = fma(-q, 1.57079632679489655800, x); r = fma(-q, 6.12323399573676603587e-17, r);
    const double r2 = r * r;
    const double sp = r * (1.0 + r2 * (-1.0 / 6 + r2 * (1.0 / 120 + r2 * (-1.0 / 5040 + r2 * (1.0 / 362880 + r2 * (-1.0 / 39916800 + r2 * (1.0 / 6227020800.0)))))));
    const double cp = 1.0 + r2 * (-0.5 + r2 * (1.0 / 24 + r2 * (-1.0 / 720 + r2 * (1.0 / 40320 + r2 * (-1.0 / 3628800 + r2 * (1.0 / 479001600 + r2 * (-1.0 / 87178291200.0)))))));
    switch (iq & 3) { case 0: s = sp; c = cp; break; case 1: s = cp; c = -sp; break; case 2: s = -sp; c = -cp; break; default: s = -cp; c = sp; break; }
}
__device__ __forceinline__ void ssm_tables(const Frame& F, CArgs& a, int l, int g, int qt) {
    LAS float* PW = (LAS float*)F.lds;
    LAS float* BB = (LAS float*)(F.lds + 33280);
    LAS float* CC = (LAS float*)(F.lds + 41472);
    const int lg = l * SSG + g;
    const double dt = exp((double)a.log_dt[lg]);
    for (int idx = F.tid; idx < 64 * 65; idx += 512) { const int p = idx / 65, d = idx % 65;
        const double re = a.lam_re[lg * 64 + p], im = a.lam_im[lg * 64 + p];
        const double mag = exp(re * dt * d), ang = im * dt * d; double sn, cs; sincos_d(ang, sn, cs);
        PW[idx * 2] = (float)(mag * cs); PW[idx * 2 + 1] = (float)(mag * sn); }
    for (int idx = F.tid; idx < 64 * 16; idx += 512) { const int p = idx >> 4, c = idx & 15;
        const double re = a.lam_re[lg * 64 + p], im = a.lam_im[lg * 64 + p];
        double sn, cs; sincos_d(im * dt, sn, cs);
        const double mag = exp(re * dt), lbr = mag * cs - 1.0, lbi = mag * sn;
        const double den = re * re + im * im; const double fr_ = (lbr * re + lbi * im) / den, fi_ = (lbi * re - lbr * im) / den;
        const double br = a.b_re[((size_t)lg * 64 + p) * 16 + c], bi = a.b_im[((size_t)lg * 64 + p) * 16 + c];
        BB[idx * 2] = (float)(fr_ * br - fi_ * bi); BB[idx * 2 + 1] = (float)(fr_ * bi + fi_ * br); }
    for (int idx = F.tid; idx < 16 * 64; idx += 512) { CC[idx * 2] = a.c_re[(size_t)lg * 1024 + idx]; CC[idx * 2 + 1] = a.c_im[(size_t)lg * 1024 + idx]; }
    __syncthreads();
    unsigned char* tab = a.ws + WS_SSMTAB + (size_t)l * SSMTAB_LAYER;
    bf16* KD = (bf16*)(tab + ST_KD) + (size_t)g * 64 * 256;
    for (int idx = qt * 2048 + F.tid; idx < (qt + 1) * 2048; idx += 512) { const int d = idx >> 8, c = (idx >> 4) & 15, c2 = idx & 15; float s = 0.f;
#pragma unroll 8
        for (int p = 0; p < 64; ++p) { const float cr = CC[(c * 64 + p) * 2], ci = CC[(c * 64 + p) * 2 + 1], pr = PW[(p * 65 + d) * 2], pi = PW[(p * 65 + d) * 2 + 1];
            const float tr = cr * pr - ci * pi, ti = cr * pi + ci * pr; s += tr * BB[(p * 16 + c2) * 2] - ti * BB[(p * 16 + c2) * 2 + 1]; }
        if (d == 0 && c == c2) s += a.ssm_d[lg * 16 + c];
        KD[idx] = (bf16)f2bf(s); }
    bf16* WST = (bf16*)(tab + ST_WST) + (size_t)g * 4 * 64 * 512;
    for (int idx = qt * 16384 + F.tid; idx < (qt + 1) * 16384; idx += 512) { const int jj = idx & 7, ln = (idx >> 3) & 63, ks = (idx >> 9) & 63, rt = idx >> 15;
        const int rho = 32 * rt + (ln & 31), p = rho >> 1, ri = rho & 1, j = ks, c2 = 8 * (ln >> 5) + jj;
        const float pr = PW[(p * 65 + 63 - j) * 2], pi = PW[(p * 65 + 63 - j) * 2 + 1], br = BB[(p * 16 + c2) * 2], bi = BB[(p * 16 + c2) * 2 + 1];
        WST[idx] = (bf16)f2bf(ri ? (pr * bi + pi * br) : (pr * br - pi * bi)); }
    bf16* VIN = (bf16*)(tab + ST_VIN) + (size_t)g * 32 * 8 * 512;
    for (int idx = qt * 16384 + F.tid; idx < (qt + 1) * 16384; idx += 512) { const int jj = idx & 7, ln = (idx >> 3) & 63, ks = (idx >> 9) & 7, rt = idx >> 12;
        const int row = 32 * rt + (ln & 31), i = row >> 4, c = row & 15, k = 16 * ks + 8 * (ln >> 5) + jj, p = k >> 1, ri = k & 1;
        const float cr = CC[(c * 64 + p) * 2], ci = CC[(c * 64 + p) * 2 + 1], pr = PW[(p * 65 + i + 1) * 2], pi = PW[(p * 65 + i + 1) * 2 + 1];
        VIN[idx] = (bf16)f2bf(ri ? -(cr * pi + ci * pr) : (cr * pr - ci * pi)); }
    float* LAM = (float*)(tab + ST_LAM) + g * 128;
    if (qt == 0 && F.tid < 64) { LAM[F.tid * 2] = PW[(F.tid * 65 + 64) * 2]; LAM[F.tid * 2 + 1] = PW[(F.tid * 65 + 64) * 2 + 1]; }
    __syncthreads();
}

constexpr int I_IN = 37 * 16, I_UQ = 24 * 4, I_UKV = 32 * 2, I_GLU = 8 * 4, I_OUT = 32 * 16, I_W1 = 32 * 16 * 16, I_W2 = 32 * 32 * 8;
constexpr int I_LAYER = I_IN + I_UQ + I_UKV + I_GLU + I_OUT + 2 * I_W1 + I_W2;
__device__ __forceinline__ void decode_item(CArgs& a, int it, TItem& t) {
        const int l = it / I_LAYER; int r = it % I_LAYER;
        if (r < I_IN) { const int nb = r / 16, kb = r % 16, n0 = nb * 32;
            t = TItem{a.w_in + (size_t)l * 1024 * INPROJ, a.mix_norm + l * 1024, (bf16*)(a.ws + WS_WIN) + (size_t)l * 1280 * 1024, INPROJ, kb * 64, n0, 1024, n0 < 416 ? n0 : n0 + 96}; return; } r -= I_IN;
        if (r < I_UQ) { const int nb = r / 4, kb = r % 4;
            t = TItem{a.w_uq + (size_t)l * 256 * 768, a.q_a_norm + l * 256, (bf16*)(a.ws + WS_WUQ) + (size_t)l * 1024 * 256, 768, kb * 64, nb * 32, 256, (nb / 3) * 128 + (nb % 3) * 32}; return; } r -= I_UQ;
        if (r < I_UKV) { const int nb = r / 2, kb = r % 2;
            t = TItem{a.w_ukv + (size_t)l * 128 * 1024, a.kv_a_norm + l * 128, (bf16*)(a.ws + WS_WUKV) + (size_t)l * 1024 * 256, 1024, kb * 64, nb * 32, 256, nb * 32}; return; } r -= I_UKV;
        if (r < I_GLU) { const int nb = r / 4, kb = r % 4;
            t = TItem{a.w_glu + (size_t)l * 256 * 256, nullptr, (bf16*)(a.ws + WS_WGLU) + (size_t)l * 256 * 256, 256, kb * 64, nb * 32, 256, nb * 32}; return; } r -= I_GLU;
        if (r < I_OUT) { const int nb = r / 16, kb = r % 16;
            t = TItem{a.w_out + (size_t)l * 1024 * 1024, a.out_norm + l * 1024, (bf16*)(a.ws + WS_WOUT) + (size_t)l * 1024 * 1024, 1024, kb * 64, nb * 32, 1024, nb * 32}; return; } r -= I_OUT;
        if (r < 2 * I_W1) { const int which = r / I_W1; r %= I_W1; const int e = r / 256, q = r % 256, nb = q / 16, kb = q % 16;
            t = TItem{(which ? a.w3 : a.w1) + ((size_t)l * NEXP + e) * 1024 * 512, a.ffn_norm + l * 1024, (bf16*)(a.ws + WS_W13) + (size_t)l * NEXP * 1024 * 1024, 512, kb * 64, nb * 32, 1024,
                      e * 1024 + (nb / 4) * 256 + which * 128 + (nb % 4) * 32}; return; } r -= 2 * I_W1;
        { const int e = r / 256, q = r % 256, nb = q / 8, kb = q % 8;
            t = TItem{a.w2 + ((size_t)l * NEXP + e) * 512 * 1024, nullptr, (bf16*)(a.ws + WS_W2) + (size_t)l * NEXP * 1024 * 512, 1024, kb * 64, nb * 32, 512, e * 1024 + nb * 32}; }
}

__device__ __forceinline__ void phase_prologue(const Frame& F, CArgs& a) {
    for (int task = F.vcu; task < 256; task += F.G) ssm_tables(F, a, task >> 7, (task >> 3) & 15, task & 7);
    LAS float* scr = (LAS float*)(F.lds + F.wave * 16384);
    const int gw = F.vcu * 8 + F.wave, NGW = F.G * 8;
    {
        TItem tc, tn; f32x4 vc[8], vn[8]; float gc[8], gn[8];
        int it = gw;
        if (it < 2 * I_LAYER) { decode_item(a, it, tc); titem_load(tc, vc, gc, F.lane); }
        while (it < 2 * I_LAYER) {
            const int nx = it + NGW; const bool hn = nx < 2 * I_LAYER;
            if (hn) { decode_item(a, nx, tn); titem_load(tn, vn, gn, F.lane); }
            titem_store(tc, vc, gc, scr, F.lane);
            if (hn) { tc = tn;
#pragma unroll
                for (int i = 0; i < 8; ++i) { vc[i] = vn[i]; gc[i] = gn[i]; } }
            it = nx;
        }
    }
    const int gt = F.vcu * 512 + F.tid, NGT = F.G * 512;
    for (int l = 0; l < 2; ++l) {
        u32x4 z4 = (u32x4){0u, 0u, 0u, 0u};
        { u32x4* p = (u32x4*)((bf16*)(a.ws + WS_WIN) + ((size_t)l * 1280 + 416) * 1024); for (int i = gt; i < 96 * 128; i += NGT) p[i] = z4; }
        { bf16* base = (bf16*)(a.ws + WS_WUQ) + (size_t)l * 1024 * 256; for (int i = gt; i < 8 * 32 * 32; i += NGT) { const int h = i >> 10, rr = (i >> 5) & 31, cc = i & 31; *(u32x4*)(base + (size_t)(h * 128 + 96 + rr) * 256 + cc * 8) = z4; } }
        { bf16* base = (bf16*)(a.ws + WS_WUKV) + (size_t)l * 1024 * 256; for (int i = gt; i < 1024 * 16; i += NGT) { const int rr = i >> 4, cc = i & 15; *(u32x4*)(base + (size_t)rr * 256 + 128 + cc * 8) = z4; } }
    }
    for (int i = gt; i < 2 * 1024 * 40; i += NGT) { const int l = i / (1024 * 40), k = (i / 40) % 1024, j = i % 40; float v = 0.f;
        if (j < 4) v = a.w_grp[((size_t)l * 1024 + k) * 4 + j]; else if (j < 36) v = a.w_exp[((size_t)l * 1024 + k) * 32 + (j - 4)];
        ((float*)(a.ws + WS_ROUTER))[i] = v * a.ffn_norm[l * 1024 + k]; }
    for (int i = gt; i < NTOK * 16; i += NGT) { const int t = i >> 4, j = i & 15;
        const float inv = (float)exp(-(double)(2 * j) / 32.0 * 9.210340371976184); const float ang = (float)a.pos[t] * inv;
        double sn, cs; sincos_d((double)ang, sn, cs);
        ((float*)(a.ws + WS_COS))[i] = (float)cs; ((float*)(a.ws + WS_SIN))[i] = (float)sn; }
    for (int m = gw; m < NTOK; m += NGW) {
        const f32x4* xr = (const f32x4*)(a.x + (size_t)m * DM) + F.lane; f32x4 v[4]; float s = 0.f;
#pragma unroll
        for (int j = 0; j < 4; ++j) { v[j] = xr[64 * j]; s += (v[j].x * v[j].x + v[j].y * v[j].y) + (v[j].z * v[j].z + v[j].w * v[j].w); }
        s = wave_sum(s);
        u32x2* o = (u32x2*)((bf16*)(a.ws + WS_XB) + (size_t)m * DM) + F.lane;
#pragma unroll
        for (int j = 0; j < 4; ++j) { u32x2 w; w.x = pk2(v[j].x, v[j].y); w.y = pk2(v[j].z, v[j].w); o[64 * j] = w; }
        if (F.lane == 0) ((float*)(a.ws + WS_SMALL + SM_RSTD1))[m] = 1.0f / sqrtf(s * (1.0f / DM) + EPS);
    }
}
__device__ __forceinline__ void phase_prep(const Frame& F, CArgs& a, int l) {
    const bf16* qraw = (const bf16*)(a.ws + WS_QRAW); const bf16* kvraw = (const bf16*)(a.ws + WS_KVRAW); const bf16* ckv = (const bf16*)(a.ws + WS_CKV);
    bf16* Q = (bf16*)(a.ws + WS_Q); bf16* K = (bf16*)(a.ws + WS_K); bf16* V = (bf16*)(a.ws + WS_V);
    const float* cosT = (const float*)(a.ws + WS_COS); const float* sinT = (const float*)(a.ws + WS_SIN);
    const float* gq = a.q_norm + l * QKH; const float* gk = a.k_norm + l * QKH;
    const int lane = F.lane, head = lane >> 3, s = lane & 7;
    const float QSCALE = 0.10206207261596577f * 1.4426950408889634f;
    f32x4 gqv[3], gkv[3];
#pragma unroll
    for (int i = 0; i < 3; ++i) { gqv[i] = *(const f32x4*)(gq + 32 * i + 4 * s); gkv[i] = *(const f32x4*)(gk + 32 * i + 4 * s); }
    const int gw = F.vcu * 8 + F.wave, NGW = F.G * 8;
    for (int t = gw; t < NTOK; t += NGW) {
        const f32x4 cs = *(const f32x4*)(cosT + (size_t)t * 16 + 4 * (s & 3)), sn = *(const f32x4*)(sinT + (size_t)t * 16 + 4 * (s & 3));
        u32x2 lq[3], lk[3], lv[2];
#pragma unroll
        for (int i = 0; i < 3; ++i) lq[i] = *(const u32x2*)(qraw + (size_t)t * 1024 + head * 128 + 32 * i + 4 * s);
#pragma unroll
        for (int i = 0; i < 2; ++i) { lk[i] = *(const u32x2*)(kvraw + (size_t)t * 1024 + head * 128 + 32 * i + 4 * s); lv[i] = *(const u32x2*)(kvraw + (size_t)t * 1024 + head * 128 + 64 + 32 * i + 4 * s); }
        lk[2] = *(const u32x2*)(ckv + (size_t)t * 256 + 128 + 4 * s);
        f32x4 v[3]; float ss = 0.f;
#pragma unroll
        for (int i = 0; i < 3; ++i) { const u32x2 w = lq[i];
            v[i] = (f32x4){bflo(w.x), bfhi(w.x), bflo(w.y), bfhi(w.y)}; ss += (v[i].x * v[i].x + v[i].y * v[i].y) + (v[i].z * v[i].z + v[i].w * v[i].w); }
        ss += __shfl_xor(ss, 1); ss += __shfl_xor(ss, 2); ss += __shfl_xor(ss, 4);
        float rs = 1.0f / sqrtf(ss * (1.0f / 96.0f) + EPS);
#pragma unroll
        for (int i = 0; i < 3; ++i) v[i] = v[i] * rs * gqv[i];
        {
            f32x4 o; f32x4 pv;
#pragma unroll
            for (int e = 0; e < 4; ++e) pv[e] = __shfl_xor(v[2][e], 4);
#pragma unroll
            for (int e = 0; e < 4; ++e) o[e] = (s < 4) ? (v[2][e] * cs[e] - pv[e] * sn[e]) : (pv[e] * sn[e] + v[2][e] * cs[e]);
            v[2] = o;
        }
#pragma unroll
        for (int i = 0; i < 3; ++i) { u32x2 w; w.x = pk2(v[i].x * QSCALE, v[i].y * QSCALE); w.y = pk2(v[i].z * QSCALE, v[i].w * QSCALE);
            *(u32x2*)(Q + (size_t)t * 768 + head * 96 + 32 * i + 4 * s) = w; }
        f32x4 kk[3]; float ks = 0.f;
#pragma unroll
        for (int i = 0; i < 2; ++i) { const u32x2 w = lk[i];
            kk[i] = (f32x4){bflo(w.x), bfhi(w.x), bflo(w.y), bfhi(w.y)}; ks += (kk[i].x * kk[i].x + kk[i].y * kk[i].y) + (kk[i].z * kk[i].z + kk[i].w * kk[i].w); }
        { const u32x2 w = lk[2];
            kk[2] = (f32x4){bflo(w.x), bfhi(w.x), bflo(w.y), bfhi(w.y)}; ks += (kk[2].x * kk[2].x + kk[2].y * kk[2].y) + (kk[2].z * kk[2].z + kk[2].w * kk[2].w); }
        ks += __shfl_xor(ks, 1); ks += __shfl_xor(ks, 2); ks += __shfl_xor(ks, 4);
        rs = 1.0f / sqrtf(ks * (1.0f / 96.0f) + EPS);
#pragma unroll
        for (int i = 0; i < 3; ++i) kk[i] = kk[i] * rs * gkv[i];
        {
            f32x4 o; f32x4 pv;
#pragma unroll
            for (int e = 0; e < 4; ++e) pv[e] = __shfl_xor(kk[2][e], 4);
#pragma unroll
            for (int e = 0; e < 4; ++e) o[e] = (s < 4) ? (kk[2][e] * cs[e] - pv[e] * sn[e]) : (pv[e] * sn[e] + kk[2][e] * cs[e]);
            kk[2] = o;
        }
#pragma unroll
        for (int i = 0; i < 3; ++i) { u32x2 w; w.x = pk2(kk[i].x, kk[i].y); w.y = pk2(kk[i].z, kk[i].w);
            *(u32x2*)(K + (size_t)t * 768 + head * 96 + 32 * i + 4 * s) = w; }
#pragma unroll
        for (int i = 0; i < 2; ++i) { const u32x2 w = lv[i];
            *(u32x2*)(V + (size_t)t * 512 + head * 64 + 32 * i + 4 * s) = w; }
    }
}

__device__ __forceinline__ void conv_unit(const Frame& F, CArgs& a, int l, int unit) {
    LAS float* UL = (LAS float*)F.lds;
    LAS float* WL = (LAS float*)(F.lds + 94 * 256 * 4);
    const bf16* ca = (const bf16*)(a.ws + WS_CONVA); const bf16* cg = (const bf16*)(a.ws + WS_CONVG); bf16* Y = (bf16*)(a.ws + WS_Y);
    const int b = unit >> 5, t0 = (unit & 31) * 64;
    __syncthreads();
    for (int idx = F.tid; idx < 94 * 64; idx += 512) { const int r = idx >> 6, c4 = idx & 63, t = t0 - 30 + r;
        f32x4 u = (f32x4){0.f, 0.f, 0.f, 0.f};
        if (t >= 0) { const size_t off = ((size_t)(b * SEQ + t)) * 256 + c4 * 4; const u32x2 wa = *(const u32x2*)(ca + off), wg = *(const u32x2*)(cg + off);
            u.x = bflo(wa.x) * sigmoidf_(bflo(wg.x)); u.y = bfhi(wa.x) * sigmoidf_(bfhi(wg.x)); u.z = bflo(wa.y) * sigmoidf_(bflo(wg.y)); u.w = bfhi(wa.y) * sigmoidf_(bfhi(wg.y)); }
        *(LAS f32x4*)(UL + r * 256 + c4 * 4) = u; }
    for (int idx = F.tid; idx < 31 * 64; idx += 512) *(LAS f32x4*)(WL + idx * 4) = *(const f32x4*)(a.dw_w + (size_t)l * 31 * 256 + idx * 4);
    __syncthreads();
    const int c0 = F.lane * 4;
    const f32x4 bias = *(const f32x4*)(a.dw_b + l * 256 + c0), lw = *(const f32x4*)(a.ln_w + l * 256 + c0), lb = *(const f32x4*)(a.ln_b + l * 256 + c0);
    for (int tt = 0; tt < 8; ++tt) { const int tok = F.wave * 8 + tt;
        f32x4 acc = bias;
#pragma unroll
        for (int k = 0; k < 31; ++k) acc += *(const LAS f32x4*)(WL + k * 256 + c0) * *(const LAS f32x4*)(UL + (tok + k) * 256 + c0);
        const float mean = wave_sum((acc.x + acc.y) + (acc.z + acc.w)) * (1.0f / 256.0f);
        const f32x4 dv = acc - mean;
        const float var = wave_sum((dv.x * dv.x + dv.y * dv.y) + (dv.z * dv.z + dv.w * dv.w)) * (1.0f / 256.0f);
        const float rstd = 1.0f / sqrtf(var + 1e-5f);
        f32x4 yv = dv * rstd * lw + lb;
#pragma unroll
        for (int e = 0; e < 4; ++e) yv[e] = yv[e] * sigmoidf_(yv[e]);
        const float ms = wave_sum((yv.x * yv.x + yv.y * yv.y) + (yv.z * yv.z + yv.w * yv.w)) * (1.0f / 256.0f);
        const float rr = 1.0f / sqrtf(ms + EPS);
        u32x2 w; w.x = pk2(yv.x * rr, yv.y * rr); w.y = pk2(yv.z * rr, yv.w * rr);
        *(u32x2*)(Y + ((size_t)(b * SEQ + t0 + tok)) * 1024 + 768 + c0) = w; }
    __syncthreads();
}

__device__ __forceinline__ void ssm_unit(const Frame& F, CArgs& a, int l, int unit) {
    const int b = unit >> 4, g = unit & 15;
    LAS unsigned char* KDL = F.lds;
    LAS unsigned char* UL = F.lds + 32768;
    LAS float* SP = (LAS float*)(F.lds + 98304);
    LAS float* SS = (LAS float*)(F.lds + 114688);
    LAS unsigned char* XIN = F.lds + 98304;
    const unsigned char* tab = a.ws + WS_SSMTAB + (size_t)l * SSMTAB_LAYER;
    const bf16* KD = (const bf16*)(tab + ST_KD) + (size_t)g * 64 * 256;
    const bf16* WST = (const bf16*)(tab + ST_WST) + (size_t)g * 4 * 64 * 512;
    const bf16* VIN = (const bf16*)(tab + ST_VIN) + (size_t)g * 32 * 8 * 512;
    const float* LAM = (const float*)(tab + ST_LAM) + g * 128;
    const bf16* U = (const bf16*)(a.ws + WS_USSM) + (size_t)(b * 16 + g) * 64 * 512;
    bf16* Z = (bf16*)(a.ws + WS_Z);
    const int lane = F.lane, w = F.wave, r32 = lane & 31, hi = lane >> 5;
    __syncthreads();
    { u32x4 t0[4], t1[8];
#pragma unroll
      for (int i = 0; i < 4; ++i) t0[i] = *(const u32x4*)((const unsigned char*)KD + (F.tid + 512 * i) * 16);
#pragma unroll
      for (int i = 0; i < 8; ++i) t1[i] = *(const u32x4*)((const unsigned char*)U + (F.tid + 512 * i) * 16);
#pragma unroll
      for (int i = 0; i < 4; ++i) *(LAS u32x4*)(KDL + (F.tid + 512 * i) * 16) = t0[i];
#pragma unroll
      for (int i = 0; i < 8; ++i) *(LAS u32x4*)(UL + (F.tid + 512 * i) * 16) = t1[i]; }
    const int rt4 = w & 3, kh = w >> 2;
    const bf16* wst_w = WST + ((size_t)(rt4 * 64 + kh * 32) * 64 + lane) * 8;
    __syncthreads();
    f32x16 acc[4];
#pragma unroll
    for (int q = 0; q < 4; ++q) acc[q] = (f32x16){};
    const int isub = r32 >> 4, cc = r32 & 15;
    const LAS unsigned char* ufp = UL + r32 * 32 + hi * 16;
    for (int j = 0; j < 64; ++j) {
        const bf16x8 uf = *(const LAS bf16x8*)(ufp + j * 1024);
#pragma unroll
        for (int q = 0; q < 4; ++q) { const int rt = w + 8 * q;
            if (2 * rt + 1 >= j) { const int d = 2 * rt + isub - j; bf16x8 af = (bf16x8){0, 0, 0, 0, 0, 0, 0, 0};
                if (d >= 0) af = *(const LAS bf16x8*)(KDL + ((d * 16 + cc) * 16 + 8 * hi) * 2);
                acc[q] = __builtin_amdgcn_mfma_f32_32x32x16_bf16(af, uf, acc[q], 0, 0, 0); } }
    }
    {
        f32x16 sacc = (f32x16){};
        for (int k8 = 0; k8 < 4; ++k8) { bf16x8 af[8];
#pragma unroll
            for (int i = 0; i < 8; ++i) af[i] = *(const bf16x8*)(wst_w + (size_t)(k8 * 8 + i) * 512);
#pragma unroll
            for (int i = 0; i < 8; ++i) { const bf16x8 uf = *(const LAS bf16x8*)(ufp + (kh * 32 + k8 * 8 + i) * 1024);
                sacc = __builtin_amdgcn_mfma_f32_32x32x16_bf16(af[i], uf, sacc, 0, 0, 0); } }
        if (kh == 1) {
#pragma unroll
            for (int r = 0; r < 16; ++r) SP[(32 * rt4 + (r & 3) + 8 * (r >> 2) + 4 * hi) * 32 + r32] = sacc[r]; }
        __syncthreads();
        if (kh == 0) {
#pragma unroll
            for (int r = 0; r < 16; ++r) { const int o = (32 * rt4 + (r & 3) + 8 * (r >> 2) + 4 * hi) * 32 + r32; SS[o] = sacc[r] + SP[o]; } }
        __syncthreads();
    }
    if (F.tid < 64) { const int p = F.tid; const float lr = LAM[2 * p], li = LAM[2 * p + 1]; float sr = 0.f, si = 0.f;
#pragma unroll 8
        for (int n = 0; n < 32; ++n) {
            *(LAS unsigned*)(XIN + n * 272 + p * 4) = pk2(sr, si);
            const float ar = SS[(2 * p) * 32 + n], ai = SS[(2 * p + 1) * 32 + n];
            const float nr = lr * sr - li * si + ar, ni = lr * si + li * sr + ai; sr = nr; si = ni; } }
    __syncthreads();
#pragma unroll
    for (int q = 0; q < 4; ++q) { const int rt = w + 8 * q; bf16x8 af[8];
#pragma unroll
        for (int ks = 0; ks < 8; ++ks) af[ks] = *(const bf16x8*)(VIN + ((size_t)(rt * 8 + ks) * 64 + lane) * 8);
#pragma unroll
        for (int ks = 0; ks < 8; ++ks) {
            const bf16x8 xf = *(const LAS bf16x8*)(XIN + r32 * 272 + (16 * ks + 8 * hi) * 2);
            acc[q] = __builtin_amdgcn_mfma_f32_32x32x16_bf16(af[ks], xf, acc[q], 0, 0, 0); } }
#pragma unroll
    for (int q = 0; q < 4; ++q) { const int rt = w + 8 * q;
#pragma unroll
        for (int rq = 0; rq < 4; ++rq) { const int rowp = 8 * rq + 4 * hi, i = 2 * rt + (rowp >> 4), c0 = rowp & 15;
            u32x2 wv; wv.x = pk2(gelu_tanh(acc[q][4 * rq]), gelu_tanh(acc[q][4 * rq + 1])); wv.y = pk2(gelu_tanh(acc[q][4 * rq + 2]), gelu_tanh(acc[q][4 * rq + 3]));
            *(u32x2*)(Z + ((size_t)(b * SEQ + r32 * 64 + i)) * 256 + g * 16 + c0) = wv; } }
    __syncthreads();
}
typedef short v4i16_t __attribute__((ext_vector_type(4)));
__device__ __forceinline__ s16x4 vtr(const LAS unsigned char* p) { return __builtin_bit_cast(s16x4, __builtin_amdgcn_ds_read_tr16_b64_v4i16((LAS v4i16_t*)p)); }
__device__ __forceinline__ int crow(int r, int hi) { return (r & 3) + 8 * (r >> 2) + 4 * hi; }
constexpr int AT_K = 0, AT_KSLOT = 12288, AT_V = 24576, AT_VSLOT = 8192, AT_WSF = 40960, AT_OST = 43008;
__device__ __forceinline__ void attn_unit(const Frame& F, CArgs& a, int b, int h, int qb) {
    const bf16* Q = (const bf16*)(a.ws + WS_Q); const bf16* K = (const bf16*)(a.ws + WS_K); const bf16* V = (const bf16*)(a.ws + WS_V);
    bf16* Y = (bf16*)(a.ws + WS_Y); float* ssqo = (float*)(a.ws + WS_SMALL + SM_SSQO);
    const int lane = F.lane, w = F.wave, r32 = lane & 31, hi = lane >> 5;
    const int NT = 4 * qb + 4, NTw = 4 * qb + (w >> 1) + 1;
    const size_t rowbase = (size_t)b * SEQ;
    const bf16* Kh = K + rowbase * 768 + h * 96; const bf16* Vh = V + rowbase * 512 + h * 64;
    LAS float* wsf = (LAS float*)(F.lds + AT_WSF) + w * 64;
    bf16x8 qr[6];
    { const bf16* Qw = Q + (rowbase + qb * 256 + w * 32 + r32) * 768 + h * 96 + 8 * hi;
#pragma unroll
      for (int d0 = 0; d0 < 6; ++d0) qr[d0] = *(const bf16x8*)(Qw + 16 * d0); }
    const bf16* ksrc0 = Kh + (size_t)lane * 768 + 8 * w;
    const bf16* ksrc1 = Kh + (size_t)lane * 768 + 8 * (8 + (w & 3));
    const bf16* vsrc = Vh + (size_t)(16 * (w & 3) + (lane >> 2)) * 512 + (w >> 2) * 32 + (lane & 3) * 8;
#define AT_ISSUE(t, s) do { \
        __builtin_amdgcn_global_load_lds((const unsigned*)(ksrc0 + (size_t)(t) * 64 * 768), (LAS unsigned*)(F.lds + AT_K + (s) * AT_KSLOT + w * 1024), 16, 0, 0); \
        if (w < 4) __builtin_amdgcn_global_load_lds((const unsigned*)(ksrc1 + (size_t)(t) * 64 * 768), (LAS unsigned*)(F.lds + AT_K + (s) * AT_KSLOT + (8 + w) * 1024), 16, 0, 0); \
        __builtin_amdgcn_global_load_lds((const unsigned*)(vsrc + (size_t)(t) * 64 * 512), (LAS unsigned*)(F.lds + AT_V + (s) * AT_VSLOT + w * 1024), 16, 0, 0); } while (0)
    float m_run = -1e30f, l_run = 0.f; f32x16 o0 = (f32x16){}, o1 = (f32x16){};
    __syncthreads();
    AT_ISSUE(0, 0);
    asm volatile("s_waitcnt vmcnt(0)" ::: "memory"); __syncthreads();
    for (int t = 0; t < NT; ++t) {
        const int s = t & 1;
        if (t + 1 < NT) AT_ISSUE(t + 1, s ^ 1);
        if (t < NTw) {
            const LAS unsigned char* kb = F.lds + AT_K + s * AT_KSLOT + hi * 1024 + r32 * 16;
            f32x16 p0 = (f32x16){}, p1 = (f32x16){};
#pragma unroll
            for (int d0 = 0; d0 < 6; ++d0) {
                const bf16x8 k0 = *(const LAS bf16x8*)(kb + d0 * 2048), k1 = *(const LAS bf16x8*)(kb + d0 * 2048 + 512);
                p0 = __builtin_amdgcn_mfma_f32_32x32x16_bf16(k0, qr[d0], p0, 0, 0, 0);
                p1 = __builtin_amdgcn_mfma_f32_32x32x16_bf16(k1, qr[d0], p1, 0, 0, 0); }
            float rm = fmaxf(p0[0], p1[0]);
#pragma unroll
            for (int r = 1; r < 16; ++r) rm = fmaxf(rm, fmaxf(p0[r], p1[r]));
            rm = fmaxf(rm, __shfl_xor(rm, 32));
            const float mn = fmaxf(m_run, rm), alpha = __builtin_amdgcn_exp2f(m_run - mn); m_run = mn;
            float sl = 0.f;
#pragma unroll
            for (int r = 0; r < 16; ++r) { p0[r] = __builtin_amdgcn_exp2f(p0[r] - mn); p1[r] = __builtin_amdgcn_exp2f(p1[r] - mn); sl += p0[r] + p1[r]; }
            sl += __shfl_xor(sl, 32);
            l_run = l_run * alpha + sl;
            if (hi == 0) wsf[r32] = alpha;
            bf16x8 pa[4];
#pragma unroll
            for (int ks = 0; ks < 4; ++ks) { u32x4 pw;
#pragma unroll
                for (int e = 0; e < 4; ++e) { const int r = (ks & 1) * 8 + 2 * e; pw[e] = (ks < 2) ? pk2(p0[r], p0[r + 1]) : pk2(p1[r], p1[r + 1]); }
                pa[ks] = __builtin_bit_cast(bf16x8, pw); }
#pragma unroll
            for (int r = 0; r < 16; ++r) { const float f = wsf[crow(r, hi)]; o0[r] *= f; o1[r] *= f; }
            const LAS unsigned char* vb = F.lds + AT_V + s * AT_VSLOT + ((lane >> 4) & 1) * 32 + (lane & 3) * 8 + (4 * hi + ((lane & 15) >> 2)) * 64;
#pragma unroll
            for (int kg = 0; kg < 4; ++kg) {
                const s16x4 l0 = vtr(vb + kg * 1024), h0 = vtr(vb + kg * 1024 + 512), l1 = vtr(vb + 4096 + kg * 1024), h1 = vtr(vb + 4096 + kg * 1024 + 512);
                const bf16x8 v0 = (bf16x8){l0[0], l0[1], l0[2], l0[3], h0[0], h0[1], h0[2], h0[3]}, v1 = (bf16x8){l1[0], l1[1], l1[2], l1[3], h1[0], h1[1], h1[2], h1[3]};
                o0 = __builtin_amdgcn_mfma_f32_32x32x16_bf16(pa[kg], v0, o0, 0, 0, 0);
                o1 = __builtin_amdgcn_mfma_f32_32x32x16_bf16(pa[kg], v1, o1, 0, 0, 0); }
        }
        asm volatile("s_waitcnt vmcnt(0)" ::: "memory"); __syncthreads();
    }
#undef AT_ISSUE
    if (hi == 0) wsf[32 + r32] = l_run;
    LAS bf16* stg = (LAS bf16*)(F.lds + AT_OST) + w * 2048;
#pragma unroll
    for (int r = 0; r < 16; ++r) { const int orow = crow(r, hi); const float rl = 1.0f / wsf[32 + orow];
        stg[orow * 64 + r32] = (bf16)f2bf(o0[r] * rl); stg[orow * 64 + 32 + r32] = (bf16)f2bf(o1[r] * rl); }
    asm volatile("s_waitcnt lgkmcnt(0)" ::: "memory");
#pragma unroll
    for (int i = 0; i < 4; ++i) { const int row = i * 8 + (lane >> 3), ch = lane & 7; const u32x4 v = *(const LAS u32x4*)(stg + row * 64 + ch * 8);
        const size_t tok = rowbase + qb * 256 + w * 32 + row;
        *(u32x4*)(Y + tok * 1024 + h * 64 + ch * 8) = v;
        float q = bflo(v.x) * bflo(v.x) + bfhi(v.x) * bfhi(v.x) + bflo(v.y) * bflo(v.y) + bfhi(v.y) * bfhi(v.y) + bflo(v.z) * bflo(v.z) + bfhi(v.z) * bfhi(v.z) + bflo(v.w) * bflo(v.w) + bfhi(v.w) * bfhi(v.w);
        q += __shfl_xor(q, 1); q += __shfl_xor(q, 2); q += __shfl_xor(q, 4);
        if (ch == 0) ssqo[tok * 8 + h] = q; }
    __syncthreads();
}

constexpr int RT_XS = 0, RT_WS = 33024, RT_PART = 0, RT_LG = 8 * 64 * 37 * 4, RT_SSQ = RT_LG + 64 * 36 * 4, RT_CNT = RT_SSQ + 256, RT_BASE = RT_CNT + 128;
__device__ __forceinline__ void phase_router(const Frame& F, CArgs& a, int l) {
    LAS float* XS = (LAS float*)(F.lds + RT_XS);
    LAS float* WSL = (LAS float*)(F.lds + RT_WS);
    LAS float* PART = (LAS float*)(F.lds + RT_PART);
    LAS float* LG = (LAS float*)(F.lds + RT_LG);
    LAS float* SSQ = (LAS float*)(F.lds + RT_SSQ);
    LAS int* CNT = (LAS int*)(F.lds + RT_CNT); LAS int* BASE = (LAS int*)(F.lds + RT_BASE);
    const float* RT = (const float*)(a.ws + WS_ROUTER) + (size_t)l * 1024 * 40;
    const float* xres = a.out; bf16* XB = (bf16*)(a.ws + WS_XB);
    unsigned* counts = (unsigned*)(a.ws + WS_CTL) + CW_CNT + l * 32;
    int* toklist = (int*)(a.ws + WS_TOKLIST); float* gatelist = (float*)(a.ws + WS_GATELIST); int* tokslot = (int*)(a.ws + WS_SMALL + SM_TOKSLOT);
    float* rstd2 = (float*)(a.ws + WS_SMALL + SM_RSTD2);
    const int w = F.wave, lane = F.lane;
    for (int tile = F.vcu; tile < NTOK / 64; tile += F.G) {
        const int tok0 = tile * 64;
        float acc[37];
#pragma unroll
        for (int j = 0; j < 37; ++j) acc[j] = 0.f;
        f32x4 xv[4], wv[3];
#define RT_LOAD(kc) do { _Pragma("unroll") for (int i = 0; i < 4; ++i) { const int idx = F.tid + 512 * i, row = idx >> 5, c4 = idx & 31; \
                xv[i] = *(const f32x4*)(xres + (size_t)(tok0 + row) * 1024 + (kc) * 128 + c4 * 4); } \
            _Pragma("unroll") for (int i = 0; i < 3; ++i) { const int idx = F.tid + 512 * i; if (idx < 1280) wv[i] = *(const f32x4*)(RT + (size_t)(kc) * 128 * 40 + idx * 4); } } while (0)
        RT_LOAD(0);
        for (int kc = 0; kc < 8; ++kc) {
            __syncthreads();
#pragma unroll
            for (int i = 0; i < 4; ++i) { const int idx = F.tid + 512 * i, row = idx >> 5, c4 = idx & 31;
                LAS float* d = XS + row * 129 + c4 * 4; d[0] = xv[i].x; d[1] = xv[i].y; d[2] = xv[i].z; d[3] = xv[i].w;
                u32x2 wb; wb.x = pk2(xv[i].x, xv[i].y); wb.y = pk2(xv[i].z, xv[i].w); *(u32x2*)(XB + (size_t)(tok0 + row) * 1024 + kc * 128 + c4 * 4) = wb; }
#pragma unroll
            for (int i = 0; i < 3; ++i) { const int idx = F.tid + 512 * i; if (idx < 1280) *(LAS f32x4*)(WSL + idx * 4) = wv[i]; }
            __syncthreads();
            if (kc + 1 < 8) RT_LOAD(kc + 1);
#pragma unroll 4
            for (int kk = 0; kk < 16; ++kk) { const float x = XS[lane * 129 + 16 * w + kk]; const LAS float* wr_ = WSL + (16 * w + kk) * 40;
#pragma unroll
                for (int j4 = 0; j4 < 9; ++j4) { const f32x4 wq = *(const LAS f32x4*)(wr_ + 4 * j4); acc[4 * j4] += x * wq.x; acc[4 * j4 + 1] += x * wq.y; acc[4 * j4 + 2] += x * wq.z; acc[4 * j4 + 3] += x * wq.w; }
                acc[36] += x * x; }
        }
#undef RT_LOAD
        __syncthreads();
        if (F.tid < 32) CNT[F.tid] = 0;
#pragma unroll
        for (int j = 0; j < 37; ++j) PART[(w * 64 + lane) * 37 + j] = acc[j];
        __syncthreads();
        { const int tok = F.tid & 63, jg = F.tid >> 6;
            for (int j = jg; j < 37; j += 8) { float s = 0.f;
#pragma unroll
                for (int ww = 0; ww < 8; ++ww) s += PART[(ww * 64 + tok) * 37 + j];
                if (j < 36) LG[tok * 36 + j] = s; else SSQ[tok] = s; } }
        __syncthreads();
        int e_sel[2] = {0, 0}, rank[2] = {0, 0}; float gate[2] = {0.f, 0.f};
        if (F.tid < 64) { const int tok = F.tid; const float rs = 1.0f / sqrtf(SSQ[tok] * (1.0f / 1024.0f) + EPS);
            rstd2[tok0 + tok] = rs;
            float lg[4];
#pragma unroll
            for (int j = 0; j < 4; ++j) lg[j] = rs * LG[tok * 36 + j] + a.b_grp[l * 4 + j];
            int gs = 0; float gm = lg[0];
#pragma unroll
            for (int j = 1; j < 4; ++j) if (lg[j] > gm) { gm = lg[j]; gs = j; }
            float den = 0.f;
#pragma unroll
            for (int j = 0; j < 4; ++j) den += __expf(lg[j] - gm);
            const float pg = 1.0f / den;
            float le[8];
#pragma unroll
            for (int i = 0; i < 8; ++i) le[i] = rs * LG[tok * 36 + 4 + 8 * gs + i] + a.b_exp[l * 32 + 8 * gs + i];
            int i1 = 0; float v1 = le[0];
#pragma unroll
            for (int i = 1; i < 8; ++i) if (le[i] > v1) { v1 = le[i]; i1 = i; }
            int i2 = -1; float v2 = -3.0e38f;
#pragma unroll
            for (int i = 0; i < 8; ++i) if (i != i1 && le[i] > v2) { v2 = le[i]; i2 = i; }
            const float ex = __expf(v2 - v1), p1 = 1.0f / (1.0f + ex), p2 = ex * p1;
            e_sel[0] = 8 * gs + i1; e_sel[1] = 8 * gs + i2; gate[0] = pg * p1; gate[1] = pg * p2;
            rank[0] = __hip_atomic_fetch_add(CNT + e_sel[0], 1, __ATOMIC_RELAXED, __HIP_MEMORY_SCOPE_WORKGROUP);
            rank[1] = __hip_atomic_fetch_add(CNT + e_sel[1], 1, __ATOMIC_RELAXED, __HIP_MEMORY_SCOPE_WORKGROUP); }
        __syncthreads();
        if (F.tid < 32) { const int c = CNT[F.tid]; BASE[F.tid] = c ? (int)__hip_atomic_fetch_add(counts + F.tid, (unsigned)c, __ATOMIC_RELAXED, __HIP_MEMORY_SCOPE_AGENT) : 0; }
        __syncthreads();
        if (F.tid < 64) {
#pragma unroll
            for (int k = 0; k < 2; ++k) { const int e = e_sel[k], slot = BASE[e] + rank[k];
                toklist[e * 16384 + slot] = tok0 + F.tid; gatelist[e * 16384 + slot] = gate[k]; tokslot[(tok0 + F.tid) * 2 + k] = e * 16384 + slot; } }
    }
    __syncthreads();
}

__device__ __forceinline__ void moe_tables(const Frame& F, CArgs& a, int l) {
    LAS int* tab = (LAS int*)(F.lds + MISC_TAB);
    unsigned* counts = (unsigned*)(a.ws + WS_CTL) + CW_CNT + l * 32;
    __syncthreads();
    if (F.tid < 32) tab[F.tid] = (int)__hip_atomic_load(counts + F.tid, __ATOMIC_RELAXED, __HIP_MEMORY_SCOPE_AGENT);
    __syncthreads();
    if (F.tid == 0) { int s = 0; for (int e = 0; e < 32; ++e) { tab[32 + e] = s; s += (tab[e] + 255) >> 8; } tab[64] = s; }
    __syncthreads();
}

__device__ __forceinline__ void phase_combine(const Frame& F, CArgs& a, int l) {
    const LAS int* tab = (const LAS int*)(F.lds + MISC_TAB);
    const int* tokslot = (const int*)(a.ws + WS_SMALL + SM_TOKSLOT); const bf16* YR = (const bf16*)(a.ws + WS_YROWS);
    float* xres = a.out; bf16* XB = (bf16*)(a.ws + WS_XB); float* rstd1 = (float*)(a.ws + WS_SMALL + SM_RSTD1);
    const int gw = F.vcu * 8 + F.wave, NGW = F.G * 8;
    for (int tb = gw; tb < NTOK; tb += 2 * NGW) {
        int tt[2]; u32x2 yv[2][2][4]; f32x4 v[2][4];
#pragma unroll
        for (int q = 0; q < 2; ++q) { const int t = tb + q * NGW; tt[q] = t;
            const int s0 = tokslot[t * 2], s1 = tokslot[t * 2 + 1];
            const size_t r0 = (size_t)tab[32 + (s0 >> 14)] * 256 + (s0 & 16383), r1 = (size_t)tab[32 + (s1 >> 14)] * 256 + (s1 & 16383);
            const f32x4* xr = (const f32x4*)(xres + (size_t)t * 1024) + F.lane; const u32x2* y0 = (const u32x2*)(YR + r0 * 1024) + F.lane; const u32x2* y1 = (const u32x2*)(YR + r1 * 1024) + F.lane;
#pragma unroll
            for (int j = 0; j < 4; ++j) { v[q][j] = xr[64 * j]; yv[q][0][j] = y0[64 * j]; yv[q][1][j] = y1[64 * j]; } }
#pragma unroll
        for (int q = 0; q < 2; ++q) { const int t = tt[q]; float ss = 0.f; f32x4* xw = (f32x4*)(xres + (size_t)t * 1024) + F.lane;
#pragma unroll
            for (int j = 0; j < 4; ++j) { const u32x2 p = yv[q][0][j], r = yv[q][1][j]; f32x4 o = v[q][j];
                o.x = (o.x + bflo(p.x)) + bflo(r.x); o.y = (o.y + bfhi(p.x)) + bfhi(r.x); o.z = (o.z + bflo(p.y)) + bflo(r.y); o.w = (o.w + bfhi(p.y)) + bfhi(r.y);
                xw[64 * j] = o; v[q][j] = o; ss += (o.x * o.x + o.y * o.y) + (o.z * o.z + o.w * o.w); }
            if (l == 0) { ss = wave_sum(ss);
                u32x2* o = (u32x2*)(XB + (size_t)t * 1024) + F.lane;
#pragma unroll
                for (int j = 0; j < 4; ++j) { u32x2 wv; wv.x = pk2(v[q][j].x, v[q][j].y); wv.y = pk2(v[q][j].z, v[q][j].w); o[64 * j] = wv; }
                if (F.lane == 0) rstd1[t] = 1.0f / sqrtf(ss * (1.0f / 1024.0f) + EPS); } }
    }
}
constexpr int NPHASE = 1 + 9 * DEPTH;
#ifndef MK_LAUNCH_PER_PHASE
#define MK_LAUNCH_PER_PHASE 0
#endif
template <int PH> __device__ __forceinline__ void run_phase(const Frame& F_in, int l_in) {
    Frame F; int l = l_in; CArgs* ap = (CArgs*)__builtin_amdgcn_kernarg_segment_ptr();
    { int wv = F_in.wave, ln; asm volatile("v_mbcnt_lo_u32_b32 %0, -1, 0\n\tv_mbcnt_hi_u32_b32 %0, -1, %0" : "=v"(ln)); asm volatile("" : "+s"(wv));
      F.wave = wv; F.lane = ln; F.tid = wv * 64 + ln; F.lds = F_in.lds;
      int G = gridDim.x, bx = blockIdx.x; asm volatile("" : "+s"(G), "+s"(bx), "+s"(l), "+s"(ap)); F.G = G; F.vcu = (G % 8 == 0) ? (bx % 8) * (G / 8) + bx / 8 : bx; }
    CArgs& a = *ap;
    LAS unsigned char* ring = F.lds;
    const LAS float* rs_tab = (const LAS float*)(F.lds + MISC_RS);
    const LAS int* moe_tab = (const LAS int*)(F.lds + MISC_TAB);
    bf16* XB = (bf16*)(a.ws + WS_XB);
    if constexpr (PH == 0) { phase_prologue(F, a); }
    if constexpr (PH == 1) {
        pg8::Gemm g{XB, (const bf16*)(a.ws + WS_WIN) + (size_t)l * 1280 * 1024, 1024};
        pg8::StaticOrder S; S.init(NTOK, 1280, F.G, F.G == 256 ? ((F.vcu & 31) * 8 + (F.vcu >> 5)) : F.vcu);
        epi::EpiInProj E{(const float*)(a.ws + WS_SMALL + SM_RSTD1), (bf16*)(a.ws + WS_CQ), (bf16*)(a.ws + WS_CKV), (bf16*)(a.ws + WS_USSM), (bf16*)(a.ws + WS_CONVA), (bf16*)(a.ws + WS_CONVG),
                         (float*)(a.ws + WS_SMALL + SM_SSQQ), (float*)(a.ws + WS_SMALL + SM_SSQKV), (float*)(a.ws + WS_SMALL + SM_SSQPE)};
        pg8::gemm_phase<epi::EpiInProj, pg8::StaticOrder, true, -1>(ring, g, S, E, rs_tab, F.tid);
    }
    if constexpr (PH == 2) {
        { pg8::Gemm g{(const bf16*)(a.ws + WS_CQ), (const bf16*)(a.ws + WS_WUQ) + (size_t)l * 1024 * 256, 256};
          pg8::StaticOrder S; S.init(NTOK, 1024, F.G, F.G == 256 ? ((F.vcu & 31) * 8 + (F.vcu >> 5)) : F.vcu);
          epi::EpiUp E{(const float*)(a.ws + WS_SMALL + SM_SSQQ), 1.0f / 256.0f, (bf16*)(a.ws + WS_QRAW)};
          pg8::gemm_phase<epi::EpiUp, pg8::StaticOrder, true, -1>(ring, g, S, E, rs_tab, F.tid); }
    }
    if constexpr (PH == 12) {
        { pg8::Gemm g{(const bf16*)(a.ws + WS_CKV), (const bf16*)(a.ws + WS_WUKV) + (size_t)l * 1024 * 256, 256};
          pg8::StaticOrder S; S.init(NTOK, 1024, F.G, F.G == 256 ? ((F.vcu & 31) * 8 + (F.vcu >> 5)) : F.vcu);
          epi::EpiUp E{(const float*)(a.ws + WS_SMALL + SM_SSQKV), 1.0f / 128.0f, (bf16*)(a.ws + WS_KVRAW)};
          pg8::gemm_phase<epi::EpiUp, pg8::StaticOrder, true, -1>(ring, g, S, E, rs_tab, F.tid); }
    }
    if constexpr (PH == 10) {
        for (int u = F.vcu; u < 128; u += F.G) ssm_unit(F, a, l, u);
    }
    if constexpr (PH == 11) {
        for (int u = F.vcu; u < 256; u += F.G) if (u >= 128) { conv_unit(F, a, l, 2 * (u - 128)); conv_unit(F, a, l, 2 * (u - 128) + 1); }
    }
    if constexpr (PH == 3) {
        { pg8::Gemm g{(const bf16*)(a.ws + WS_Z), (const bf16*)(a.ws + WS_WGLU) + (size_t)l * 256 * 256, 256};
          pg8::StaticOrder S; S.init(NTOK, 256, F.G, F.G == 256 ? ((F.vcu & 31) * 8 + (F.vcu >> 5)) : F.vcu);
          epi::EpiGlu E{(const bf16*)(a.ws + WS_Z), (bf16*)(a.ws + WS_Y)};
          pg8::gemm_phase<epi::EpiGlu, pg8::StaticOrder, false, -1>(ring, g, S, E, rs_tab, F.tid); }
        phase_prep(F, a, l);
    }
    if constexpr (PH == 4) {
        for (int v = F.vcu; v < 256; v += F.G) { const int bh = v >> 2, s = v & 3;
            attn_unit(F, a, bh >> 3, bh & 7, s); attn_unit(F, a, bh >> 3, bh & 7, 7 - s); }
    }
    if constexpr (PH == 5) {
        pg8::Gemm g{(const bf16*)(a.ws + WS_Y), (const bf16*)(a.ws + WS_WOUT) + (size_t)l * 1024 * 1024, 1024};
        pg8::StaticOrder S; S.init(NTOK, 1024, F.G, F.G == 256 ? ((F.vcu & 31) * 8 + (F.vcu >> 5)) : F.vcu);
        pg8::Unit u0; const bool has = S.next(0, u0);
        __syncthreads();
        if (has && F.tid < 256) { const float* q = (const float*)(a.ws + WS_SMALL + SM_SSQO) + (size_t)(u0.pm * 256 + F.tid) * 8; float s = 0.f;
#pragma unroll
            for (int hh = 0; hh < 8; ++hh) s += q[hh];
            ((LAS float*)(F.lds + MISC_RS))[F.tid] = 1.0f / sqrtf(s * (1.0f / 512.0f) + EPS); }
        __syncthreads();
        epi::EpiResidual E{l == 0 ? a.x : (const float*)a.out, a.out};
        pg8::gemm_phase<epi::EpiResidual, pg8::StaticOrder, false, 8>(ring, g, S, E, rs_tab, F.tid);
    }
    if constexpr (PH == 6) phase_router(F, a, l);
    if constexpr (PH == 7) {
        moe_tables(F, a, l);
        pg8::Gemm g{XB, (const bf16*)(a.ws + WS_W13) + (size_t)l * NEXP * 1024 * 1024, 1024};
        MoeSched S{moe_tab, (const int*)(a.ws + WS_TOKLIST), F.G, F.vcu, true};
        epi::EpiMoe1 E{moe_tab, (const int*)(a.ws + WS_TOKLIST), (const float*)(a.ws + WS_SMALL + SM_RSTD2), (bf16*)(a.ws + WS_H)};
        pg8::gemm_phase<epi::EpiMoe1, MoeSched, true, -1>(ring, g, S, E, rs_tab, F.tid);
    }
    if constexpr (PH == 8) {
        moe_tables(F, a, l);
        pg8::Gemm g{(const bf16*)(a.ws + WS_H), (const bf16*)(a.ws + WS_W2) + (size_t)l * NEXP * 1024 * 512, 512};
        MoeSched S{moe_tab, (const int*)(a.ws + WS_TOKLIST), F.G, F.vcu, false};
        epi::EpiMoe2 E{moe_tab, (const float*)(a.ws + WS_GATELIST), (bf16*)(a.ws + WS_YROWS)};
        pg8::gemm_phase<epi::EpiMoe2, MoeSched, true, -1>(ring, g, S, E, rs_tab, F.tid);
    }
    if constexpr (PH == 9) { moe_tables(F, a, l); phase_combine(F, a, l); }
}
__device__ __forceinline__ void make_frame(Frame& F, unsigned char* lds_raw) {
    F.lds = (LAS unsigned char*)lds_raw;
    F.tid = threadIdx.x; F.lane = F.tid & 63; F.wave = __builtin_amdgcn_readfirstlane(F.tid >> 6);
    F.G = gridDim.x; { const int bx = blockIdx.x; F.vcu = (F.G % 8 == 0) ? (bx % 8) * (F.G / 8) + bx / 8 : bx; }
}
template <int PH> __global__ void __launch_bounds__(512, 2) k_phase(Args a, int l) {
    extern __shared__ __attribute__((aligned(16))) unsigned char lds_raw[];
    Frame F; make_frame(F, lds_raw);
    run_phase<PH>(F, l);
}
#if !MK_LAUNCH_PER_PHASE
__global__ void __launch_bounds__(512, 2) fwd_kernel(Args a) {
    extern __shared__ __attribute__((aligned(16))) unsigned char lds_raw[];
    Frame F; make_frame(F, lds_raw);
    unsigned* ctl = (unsigned*)(((CArgs*)__builtin_amdgcn_kernarg_segment_ptr())->ws + WS_CTL);
    if (F.tid < 4) ((LAS unsigned*)(F.lds + MISC_BARW))[F.tid] = 0u;
    __syncthreads();
    (void)xcd_barrier_post(ctl + CW_BAR, (volatile LAS unsigned*)(F.lds + MISC_BARW));
#define GRID_SYNC() do { unsigned* bp_ = (unsigned*)(((CArgs*)__builtin_amdgcn_kernarg_segment_ptr())->ws + WS_CTL) + CW_BAR; asm volatile("" : "+s"(bp_)); \
        XcdBarrier b_; b_.bar = bp_; b_.x = xb_xcc_id(); b_.st = (volatile LAS unsigned*)(F.lds + MISC_BARW); xcd_barrier(b_); } while (0)
#ifndef REP_MASK
#define REP_MASK 0
#endif
#define RUN(PH, l) do { run_phase<PH>(F, l); if ((REP_MASK >> PH) & 1) { GRID_SYNC(); run_phase<PH>(F, l); } } while (0)
    RUN(0, 0); GRID_SYNC();
    for (int l = 0; l < DEPTH; ++l) {
        RUN(1, l); GRID_SYNC();
        RUN(2, l); RUN(12, l); RUN(10, l); RUN(11, l); GRID_SYNC();
        RUN(3, l); GRID_SYNC();
        RUN(4, l); GRID_SYNC();
        RUN(5, l); GRID_SYNC();
        RUN(6, l); GRID_SYNC();
        RUN(7, l); GRID_SYNC();
        RUN(8, l); GRID_SYNC();
        RUN(9, l); if (l + 1 < DEPTH) GRID_SYNC();
    }
}
#endif

extern "C" void kernel_launch(void* const* d_in, const int* in_sizes, int n_in, void* d_out, int out_size, void* d_ws, size_t ws_size, hipStream_t stream) {
    static int grid = 0;
    if (grid == 0) {
        if (n_in != 33 || ws_size < WS_END) { fprintf(stderr, "kernel_launch: unexpected inputs (n_in %d, ws %zu)\n", n_in, ws_size); grid = -1; return; }
#if !MK_LAUNCH_PER_PHASE
        if (hipFuncSetAttribute((const void*)fwd_kernel, hipFuncAttributeMaxDynamicSharedMemorySize, LDS_BYTES) != hipSuccess) { grid = -1; return; }
#else
#define SA(K) if (hipFuncSetAttribute((const void*)K, hipFuncAttributeMaxDynamicSharedMemorySize, LDS_BYTES) != hipSuccess) { fprintf(stderr, "kernel_launch: hipFuncSetAttribute failed\n"); grid = -1; return; }
        SA(k_phase<0>) SA(k_phase<1>) SA(k_phase<2>) SA(k_phase<3>) SA(k_phase<4>) SA(k_phase<5>) SA(k_phase<6>) SA(k_phase<7>) SA(k_phase<8>) SA(k_phase<9>) SA(k_phase<10>) SA(k_phase<11>) SA(k_phase<12>)
#undef SA
#endif
        int per_cu = 0;
#if !MK_LAUNCH_PER_PHASE
        if (hipOccupancyMaxActiveBlocksPerMultiprocessor(&per_cu, (const void*)fwd_kernel, 512, LDS_BYTES) != hipSuccess || per_cu < 1) fprintf(stderr, "kernel_launch: occupancy query reports %d\n", per_cu);
        (void)hipGetLastError();
#endif
        (void)per_cu;
        grid = 256;
    }
    if (grid < 0) return;
    (void)hipMemsetAsync((char*)d_ws + WS_CTL, 0, CTL_ZERO_BYTES, stream);
    Args a{};

    a.x = (const float*)d_in[0]; a.pos = (const int*)d_in[1]; a.mix_norm = (const float*)d_in[2]; a.w_in = (const float*)d_in[3]; a.q_a_norm = (const float*)d_in[4];
    a.w_uq = (const float*)d_in[5]; a.kv_a_norm = (const float*)d_in[6]; a.w_ukv = (const float*)d_in[7]; a.q_norm = (const float*)d_in[8]; a.k_norm = (const float*)d_in[9];
    a.lam_re = (const float*)d_in[10]; a.lam_im = (const float*)d_in[11]; a.b_re = (const float*)d_in[12]; a.b_im = (const float*)d_in[13]; a.c_re = (const float*)d_in[14];
    a.c_im = (const float*)d_in[15]; a.ssm_d = (const float*)d_in[16]; a.log_dt = (const float*)d_in[17]; a.w_glu = (const float*)d_in[18]; a.dw_w = (const float*)d_in[19];
    a.dw_b = (const float*)d_in[20]; a.ln_w = (const float*)d_in[21]; a.ln_b = (const float*)d_in[22]; a.out_norm = (const float*)d_in[23]; a.w_out = (const float*)d_in[24];
    a.ffn_norm = (const float*)d_in[25]; a.w_grp = (const float*)d_in[26]; a.b_grp = (const float*)d_in[27]; a.w_exp = (const float*)d_in[28]; a.b_exp = (const float*)d_in[29];
    a.w1 = (const float*)d_in[30]; a.w3 = (const float*)d_in[31]; a.w2 = (const float*)d_in[32];

    a.out = (float*)d_out; a.ws = (unsigned char*)d_ws;
#if MK_LAUNCH_PER_PHASE
#define LP(PH, l) hipLaunchKernelGGL(k_phase<PH>, dim3(grid), dim3(512), LDS_BYTES, stream, a, l)
    LP(0, 0);
    for (int l = 0; l < DEPTH; ++l) { LP(1, l); LP(2, l); LP(12, l); LP(10, l); LP(11, l); LP(3, l); LP(4, l); LP(5, l); LP(6, l); LP(7, l); LP(8, l); LP(9, l); }
#undef LP
#else
    hipLaunchKernelGGL(fwd_kernel, dim3(grid), dim3(512), LDS_BYTES, stream, a);
#endif
    const hipError_t le = hipPeekAtLastError();
    if (le != hipSuccess) fprintf(stderr, "kernel_launch: launch failed: %s\n", hipGetErrorName(le));
}
```

```cpp
#define MK_LAUNCH_PER_PHASE 0
#include <hip/hip_runtime.h>
#include <cstdio>
#include <cstdint>

#define LAS __attribute__((address_space(3)))
#define GAS __attribute__((address_space(1)))
typedef unsigned short bf16;
typedef short bf16x8 __attribute__((ext_vector_type(8)));
typedef short s16x4 __attribute__((ext_vector_type(4)));
typedef float f32x4 __attribute__((ext_vector_type(4)));
typedef float f32x2 __attribute__((ext_vector_type(2)));
typedef float f32x16 __attribute__((ext_vector_type(16)));
typedef unsigned u32x4 __attribute__((ext_vector_type(4)));
typedef unsigned u32x2 __attribute__((ext_vector_type(2)));

constexpr int DM = 1024, NB = 8, SEQ = 2048, NTOK = NB * SEQ, DEPTH = 2;
constexpr int NH = 8, QK_NOPE = 64, QK_ROPE = 32, QKH = 96, VH = 64, QLORA = 256, KVLORA = 128;
constexpr int SSMW = 256, SSG = 16, SSP = 64, CONVW = 256, CONVK = 31, INPROJ = 1184;
constexpr int NEXP = 32, DFF = 512;
constexpr float EPS = 1e-6f;

constexpr size_t MiB = 1u << 20;
constexpr size_t WS_CTL = 0, CTL_ZERO_BYTES = 1 * MiB;
constexpr size_t WS_ROUTER = 1 * MiB;
constexpr size_t WS_COS = 2 * MiB, WS_SIN = 3 * MiB;
constexpr size_t WS_WIN = 4 * MiB;
constexpr size_t WS_WUQ = 9 * MiB;
constexpr size_t WS_WUKV = 10 * MiB;
constexpr size_t WS_WGLU = 11 * MiB;
constexpr size_t WS_WOUT = 12 * MiB;
constexpr size_t WS_SSMTAB = 16 * MiB;
constexpr size_t SSMTAB_LAYER = 9 * MiB, ST_KD = 0, ST_WST = 512 * 1024, ST_VIN = 512 * 1024 + 4 * MiB, ST_LAM = 512 * 1024 + 8 * MiB;
constexpr size_t WS_W13 = 34 * MiB;
constexpr size_t WS_W2 = 162 * MiB;
constexpr size_t WS_XB = 226 * MiB;
constexpr size_t WS_SMALL = 258 * MiB;
constexpr size_t SM_RSTD1 = 0, SM_RSTD2 = 64 * 1024, SM_SSQQ = 128 * 1024  , SM_SSQKV = 384 * 1024  , SM_SSQPE = 640 * 1024  ,
                 SM_SSQO = 704 * 1024  , SM_TOKSLOT = 1216 * 1024  , SM_RSLIST = 2048 * 1024  ;
constexpr size_t WS_CQ = 264 * MiB;
constexpr size_t WS_CKV = 272 * MiB;
constexpr size_t WS_USSM = 280 * MiB;
constexpr size_t WS_CONVA = 288 * MiB, WS_CONVG = 296 * MiB;
constexpr size_t WS_Z = 304 * MiB;
constexpr size_t WS_Y = 312 * MiB;
constexpr size_t WS_TOKLIST = 344 * MiB;
constexpr size_t WS_GATELIST = 346 * MiB;
constexpr size_t WS_QRAW = 348 * MiB;
constexpr size_t WS_KVRAW = 380 * MiB;
constexpr size_t WS_Q = 412 * MiB;
constexpr size_t WS_K = 436 * MiB;
constexpr size_t WS_V = 460 * MiB;
constexpr size_t WS_END = 476 * MiB;
constexpr size_t WS_H = 348 * MiB;
constexpr size_t WS_YROWS = 388 * MiB;
constexpr int MAXROWS = 40960;
constexpr int CW_BAR = 4096;
constexpr int CW_CNT = 8192;

constexpr int RING_BYTES = 131072;
constexpr int MISC_OFF = RING_BYTES;
constexpr int MISC_BARW = MISC_OFF;
constexpr int MISC_TAB = MISC_OFF + 64;
constexpr int MISC_BLK = MISC_OFF + 512;
constexpr int MISC_RS = MISC_OFF + 2048;
constexpr int LDS_BYTES = 147456;

__device__ __forceinline__ unsigned f2bf(float f) { unsigned u = __builtin_bit_cast(unsigned, f); return (u + 0x7fffu + ((u >> 16) & 1u)) >> 16; }
typedef __bf16 bf16x2_t __attribute__((ext_vector_type(2)));
__device__ __forceinline__ unsigned pk2(float lo, float hi) { f32x2 v = {lo, hi}; bf16x2_t b = __builtin_convertvector(v, bf16x2_t); return __builtin_bit_cast(unsigned, b); }
__device__ __forceinline__ float bf2f(unsigned short b) { return __builtin_bit_cast(float, (unsigned)b << 16); }
__device__ __forceinline__ float bflo(unsigned w) { return __builtin_bit_cast(float, w << 16); }
__device__ __forceinline__ float bfhi(unsigned w) { return __builtin_bit_cast(float, w & 0xffff0000u); }
#define DPP_ADD(v, ctrl) ((v) + __builtin_bit_cast(float, __builtin_amdgcn_update_dpp(0, __builtin_bit_cast(int, (v)), (ctrl), 0xf, 0xf, true)))
__device__ __forceinline__ float sum8(float v) { v = DPP_ADD(v, 0xB1); v = DPP_ADD(v, 0x4E); v = DPP_ADD(v, 0x141); return v; }
__device__ __forceinline__ float wave_sum(float v) {
    v = DPP_ADD(v, 0xB1); v = DPP_ADD(v, 0x4E); v = DPP_ADD(v, 0x141); v = DPP_ADD(v, 0x140);
    const float r0 = __builtin_bit_cast(float, __builtin_amdgcn_readlane(__builtin_bit_cast(int, v), 0)), r1 = __builtin_bit_cast(float, __builtin_amdgcn_readlane(__builtin_bit_cast(int, v), 16));
    const float r2 = __builtin_bit_cast(float, __builtin_amdgcn_readlane(__builtin_bit_cast(int, v), 32)), r3 = __builtin_bit_cast(float, __builtin_amdgcn_readlane(__builtin_bit_cast(int, v), 48));
    return (r0 + r1) + (r2 + r3);
}
__device__ __forceinline__ float sigmoidf_(float x) { return __builtin_amdgcn_rcpf(1.0f + __expf(-x)); }
__device__ __forceinline__ float gelu_tanh(float y) { const float a = 0.7978845608028654f * (y + 0.044715f * y * y * y); const float t = 1.0f - 2.0f * __builtin_amdgcn_rcpf(__expf(2.0f * a) + 1.0f); return 0.5f * y * (1.0f + t); }

namespace pg8 {
constexpr int BM = 256, BK = 64, HALF = 128, HTB = HALF * BK * 2, STAGE_BYTES = 8 * HTB, NXCD = 8, WGM = 8;
__host__ __device__ __forceinline__ int lds_byte(int r, int c) { const int st = (r >> 4) * 2 + (c >> 5), rr = r & 15, cc = c & 31, ob = rr * 64 + cc * 2; return st * 1024 + (ob ^ (((ob >> 9) & 1) << 5)); }
__host__ __device__ __forceinline__ void stage_rc(int b, int& R, int& C) { const int st = b / 1024, sb = b % 1024, swz = sb ^ (((sb >> 9) & 1) << 5); R = (st >> 1) * 16 + swz / 64; C = (st & 1) * 32 + (swz % 64) / 2; }
__host__ __device__ __forceinline__ int perm32(int rho) { const int n = rho >> 4, i = rho & 15; return 8 * (i >> 2) + 4 * n + (i & 3); }

struct Unit { int pm, pn; };
struct Gemm { const bf16* A; const bf16* Bt; int K; };

struct StaticOrder {
    int nM, nN, nwg, G, c;
    __device__ void init(int M, int N, int G_, int c_) { nM = M / BM; nN = N / BM; nwg = nM * nN; G = G_; c = c_; }
    __device__ bool next(int i, Unit& u) const {
        const long L = (long)i * G + c; if (L >= nwg) return false;
        int wgid = (int)L; { const int q = nwg / NXCD, r = nwg % NXCD, xcd = wgid % NXCD, off = wgid / NXCD; wgid = (xcd < r ? xcd * (q + 1) : r * (q + 1) + (xcd - r) * q) + off; }
        const int nig = WGM * nN, gid = wgid / nig, fm = gid * WGM, gsz = (nM - fm) < WGM ? (nM - fm) : WGM;
        u.pm = fm + ((wgid % nig) % gsz); u.pn = (wgid % nig) / gsz; return true;
    }
    __device__ __forceinline__ unsigned arow(const Unit& u, int rloc) const { return (unsigned)(u.pm * BM + rloc); }
};

template <class Epi, class Sched, bool ALIGN_EPI, int KSCALE_T>
__device__ __forceinline__ void gemm_phase(LAS unsigned char* lds, const Gemm g, const Sched& S, const Epi& E, const LAS float* rs, const int tid) {
    const int wid = __builtin_amdgcn_readfirstlane(tid >> 6), lane = tid & 63, wr = wid >> 2, wc = wid & 3, fr = lane & 15, fq = lane >> 4;
    const int K = g.K, nt = K / BK;
    int Rst[2]; unsigned cofs[2]; unsigned voffB[2];
#pragma unroll
    for (int i = 0; i < 2; ++i) { int R, C; stage_rc(tid * 16 + i * 8192, R, C); const int Rb = Epi::PERM ? ((R & ~31) + perm32(R & 31)) : R;
        Rst[i] = R; cofs[i] = (unsigned)C * 2u; voffB[i] = (unsigned)(Rb * K + C) * 2u; }
    const size_t kstep = (size_t)(BK * 2);
    const size_t hstepB = (size_t)HALF * K * 2;
    const size_t tstepB = 2 * hstepB;
    const unsigned ldsw = (unsigned)wid * 1024u;
    const int aoff = lds_byte(wr * 64 + fr, fq * 8), boff = lds_byte(wc * 32 + fr, fq * 8);
#define PG8_SA(b, h) (((b) * 2 + (h)) * HTB)
#define PG8_SB(b, h) ((4 + (b) * 2 + (h)) * HTB)
#define PG8_STAGEB(bufoff, gbase) do { _Pragma("unroll") for (int _i = 0; _i < 2; ++_i) \
        __builtin_amdgcn_global_load_lds((const unsigned*)((const char*)(gbase) + voffB[_i]), (LAS unsigned*)(lds + (bufoff) + ldsw + _i * 8192), 16, 0, 0); } while (0)
#define PG8_STAGEA(bufoff, gbase, vo, h) do { _Pragma("unroll") for (int _i = 0; _i < 2; ++_i) \
        __builtin_amdgcn_global_load_lds((const unsigned*)((const char*)(gbase) + (vo)[h][_i]), (LAS unsigned*)(lds + (bufoff) + ldsw + _i * 8192), 16, 0, 0); } while (0)
#define PG8_LDA(dst, b, h) do { _Pragma("unroll") for (int m = 0; m < 4; ++m) _Pragma("unroll") for (int k = 0; k < 2; ++k) dst[m][k] = *(const LAS bf16x8*)(lds + PG8_SA(b, h) + aoff + m * 2048 + k * 1024); } while (0)
#define PG8_LDB(dst, b, h) do { _Pragma("unroll") for (int n = 0; n < 2; ++n) _Pragma("unroll") for (int k = 0; k < 2; ++k) dst[n][k] = *(const LAS bf16x8*)(lds + PG8_SB(b, h) + boff + n * 2048 + k * 1024); } while (0)
#define PG8_MMA(ai, bj, At, Bt) do { __builtin_amdgcn_s_setprio(1); _Pragma("unroll") for (int m = 0; m < 4; ++m) _Pragma("unroll") for (int n = 0; n < 2; ++n) _Pragma("unroll") for (int k = 0; k < 2; ++k) \
        acc[ai][bj][m][n] = __builtin_amdgcn_mfma_f32_16x16x32_bf16(Bt[n][k], At[m][k], acc[ai][bj][m][n], 0, 0, 0); __builtin_amdgcn_s_setprio(0); } while (0)
#define PG8_WAIT_V(n) asm volatile("s_waitcnt vmcnt(" #n ")" ::: "memory")
#define PG8_WAIT_L(n) asm volatile("s_waitcnt lgkmcnt(" #n ")" ::: "memory")
#define PG8_BAR __builtin_amdgcn_s_barrier()
#define PG8_SCHED __builtin_amdgcn_sched_barrier(0)
#define PG8_AOFFS(vo, u) do { _Pragma("unroll") for (int _h = 0; _h < 2; ++_h) _Pragma("unroll") for (int _i = 0; _i < 2; ++_i) \
        (vo)[_h][_i] = S.arow((u), _h * HALF + Rst[_i]) * (unsigned)(K * 2) + cofs[_i]; } while (0)
    Unit cur, nxt; int ui = 0;
    if (!S.next(0, cur)) return;
    f32x4 acc[2][2][4][2];
#pragma unroll
    for (int a = 0; a < 2; ++a)
#pragma unroll
        for (int b = 0; b < 2; ++b)
#pragma unroll
            for (int m = 0; m < 4; ++m)
#pragma unroll
                for (int n = 0; n < 2; ++n) acc[a][b][m][n] = (f32x4){0.f, 0.f, 0.f, 0.f};
    bf16x8 At[4][2], B0[2][2], B1[2][2];
    unsigned voC[2][2], voN[2][2];
    PG8_AOFFS(voC, cur);
    const char* gA = (const char*)g.A;
    const char* cB = (const char*)g.Bt + (size_t)cur.pn * tstepB;
    PG8_STAGEB(PG8_SB(0, 0), cB); PG8_STAGEB(PG8_SB(0, 1), cB + hstepB); PG8_STAGEA(PG8_SA(0, 0), gA, voC, 0); PG8_STAGEA(PG8_SA(0, 1), gA, voC, 1);
    if (wr == 1) PG8_BAR;
    PG8_WAIT_V(2); PG8_BAR;
    PG8_STAGEB(PG8_SB(1, 0), cB + kstep); PG8_STAGEA(PG8_SA(1, 0), gA + kstep, voC, 0); PG8_STAGEB(PG8_SB(1, 1), cB + hstepB + kstep);
    PG8_WAIT_V(6); PG8_BAR;
    for (;;) {
        const bool has_next = S.next(ui + 1, nxt);
        if (has_next) { PG8_AOFFS(voN, nxt); } else {
#pragma unroll
            for (int _h = 0; _h < 2; ++_h)
#pragma unroll
                for (int _i = 0; _i < 2; ++_i) voN[_h][_i] = voC[_h][_i]; }
        const char* nB = has_next ? (const char*)g.Bt + (size_t)nxt.pn * tstepB : cB;
#pragma nounroll
        for (int t = 0; t < nt; t += 2) {
            const bool last = (t == nt - 2);
            if (KSCALE_T >= 0 && t == KSCALE_T) {
#pragma unroll
                for (int ai = 0; ai < 2; ++ai)
#pragma unroll
                    for (int m = 0; m < 4; ++m) { const float sc = rs[ai * HALF + wr * 64 + m * 16 + fr];
#pragma unroll
                        for (int bj = 0; bj < 2; ++bj)
#pragma unroll
                            for (int n = 0; n < 2; ++n) acc[ai][bj][m][n] *= sc; }
            }
            const char* a1 = gA + (size_t)(t + 1) * kstep;
            const char* a2 = last ? gA : gA + (size_t)(t + 2) * kstep; const char* b2 = last ? nB : cB + (size_t)(t + 2) * kstep;
            const char* a3 = a2 + kstep; const char* b3 = b2 + kstep;
            unsigned vo2[2][2];
#pragma unroll
            for (int _h = 0; _h < 2; ++_h)
#pragma unroll
                for (int _i = 0; _i < 2; ++_i) vo2[_h][_i] = last ? voN[_h][_i] : voC[_h][_i];
            PG8_LDB(B0, 0, 0); PG8_LDB(B1, 0, 1); PG8_SCHED; PG8_LDA(At, 0, 0); PG8_STAGEA(PG8_SA(1, 1), a1, voC, 1);
            PG8_WAIT_V(8); PG8_WAIT_L(0); PG8_BAR; PG8_MMA(0, 0, At, B0); PG8_MMA(0, 1, At, B1); PG8_BAR; PG8_SCHED;
            PG8_LDA(At, 0, 1); PG8_STAGEB(PG8_SB(0, 0), b2); PG8_STAGEB(PG8_SB(0, 1), b2 + hstepB); PG8_STAGEA(PG8_SA(0, 0), a2, vo2, 0);
            PG8_WAIT_V(8); PG8_WAIT_L(0); PG8_BAR; PG8_MMA(1, 0, At, B0); PG8_MMA(1, 1, At, B1); PG8_BAR; PG8_SCHED;
            PG8_LDB(B0, 1, 0); PG8_LDB(B1, 1, 1); PG8_SCHED; PG8_LDA(At, 1, 0); PG8_STAGEA(PG8_SA(0, 1), a2, vo2, 1);
            PG8_WAIT_V(8); PG8_WAIT_L(0); PG8_BAR; PG8_MMA(0, 0, At, B0); PG8_MMA(0, 1, At, B1); PG8_BAR; PG8_SCHED;
            PG8_LDA(At, 1, 1); PG8_STAGEB(PG8_SB(1, 0), b3); PG8_STAGEB(PG8_SB(1, 1), b3 + hstepB); PG8_STAGEA(PG8_SA(1, 0), a3, vo2, 0);
            PG8_WAIT_V(8); PG8_WAIT_L(0); PG8_BAR; PG8_MMA(1, 0, At, B0); PG8_MMA(1, 1, At, B1); PG8_BAR; PG8_SCHED;
        }
        if constexpr (ALIGN_EPI) { if (wr == 0) PG8_BAR; }
        if constexpr (!Epi::AFTER_DRAIN) { E(acc, cur, wr, wc, fr, fq); }
        if (!has_next) break;
#pragma unroll
        for (int a = 0; a < 2; ++a)
#pragma unroll
            for (int b = 0; b < 2; ++b)
#pragma unroll
                for (int m = 0; m < 4; ++m)
#pragma unroll
                    for (int n = 0; n < 2; ++n) acc[a][b][m][n] = (f32x4){0.f, 0.f, 0.f, 0.f};
        cur = nxt; cB = nB; ++ui;
#pragma unroll
        for (int _h = 0; _h < 2; ++_h)
#pragma unroll
            for (int _i = 0; _i < 2; ++_i) voC[_h][_i] = voN[_h][_i];
        if constexpr (ALIGN_EPI) { if (wr == 1) PG8_BAR; }
    }
    PG8_WAIT_V(0);
    if constexpr (!ALIGN_EPI) { if (wr == 0) PG8_BAR; }
    PG8_BAR;
    if constexpr (Epi::AFTER_DRAIN) { E.fused(acc, cur, wr, wc, fr, fq, lds, wid, lane); }
#undef PG8_SA
#undef PG8_SB
#undef PG8_STAGEA
#undef PG8_STAGEB
#undef PG8_LDA
#undef PG8_LDB
#undef PG8_MMA
#undef PG8_WAIT_V
#undef PG8_WAIT_L
#undef PG8_BAR
#undef PG8_SCHED
#undef PG8_AOFFS
}
}
namespace epi {
using pg8::Unit; using pg8::BM; using pg8::HALF;
__device__ __forceinline__ unsigned cvt_pk_bf16(float lo, float hi) { unsigned r; asm volatile("v_cvt_pk_bf16_f32 %0, %1, %2" : "=v"(r) : "v"(lo), "v"(hi)); return r; }
__device__ __forceinline__ u32x4 pack8(const f32x4 a, const f32x4 b) { u32x4 w; w.x = cvt_pk_bf16(a[0], a[1]); w.y = cvt_pk_bf16(a[2], a[3]); w.z = cvt_pk_bf16(b[0], b[1]); w.w = cvt_pk_bf16(b[2], b[3]); return w; }

struct EpiInProj {
    static constexpr bool PERM = true, AFTER_DRAIN = false;
    const float* rstd1; bf16* cq; bf16* ckv; bf16* ussm; bf16* conva; bf16* convg; float* ssqq; float* ssqkv; float* ssqpe;
    __device__ __forceinline__ void operator()(const f32x4 (&acc)[2][2][4][2], const Unit& u, int wr, int wc, int fr, int fq) const {
        const int cl0 = wc * 32 + 8 * fq;
#pragma unroll
        for (int ai = 0; ai < 2; ++ai)
#pragma unroll
            for (int m = 0; m < 4; ++m) {
                const int row = u.pm * BM + ai * HALF + wr * 64 + m * 16 + fr;
                const float rs = rstd1[row];
                f32x4 v[2][2];
#pragma unroll
                for (int bj = 0; bj < 2; ++bj)
#pragma unroll
                    for (int n = 0; n < 2; ++n) v[bj][n] = acc[ai][bj][m][n] * rs;
                if (u.pn == 0 || u.pn == 1) {
                    bf16* dst = (u.pn == 0) ? cq : ckv;
                    float s0 = 0.f, s1 = 0.f;
#pragma unroll
                    for (int n = 0; n < 2; ++n)
#pragma unroll
                        for (int i = 0; i < 4; ++i) { s0 += v[0][n][i] * v[0][n][i]; s1 += v[1][n][i] * v[1][n][i]; }
                    s0 += __shfl_xor(s0, 16); s0 += __shfl_xor(s0, 32); s1 += __shfl_xor(s1, 16); s1 += __shfl_xor(s1, 32);
#pragma unroll
                    for (int bj = 0; bj < 2; ++bj) *(u32x4*)(dst + (size_t)row * 256 + bj * HALF + cl0) = pack8(v[bj][0], v[bj][1]);
                    if (fq == 0) {
                        if (u.pn == 0) ssqq[row * 4 + wc] = s0 + s1;
                        else { ssqkv[row * 4 + wc] = s0; if (wc == 0) ssqpe[row] = s1; }
                    }
                } else if (u.pn == 2) {
                    const int b = row >> 11, t = row & 2047, nch = t >> 6, j = t & 63;
#pragma unroll
                    for (int bj = 0; bj < 2; ++bj) { const int c = bj * HALF + cl0, gg = c >> 4, c0 = c & 15;
                        *(u32x4*)(ussm + ((((size_t)(b * 16 + gg) * 64 + j) * 32 + nch) * 16 + c0)) = pack8(v[bj][0], v[bj][1]); }
                } else {
                    bf16* dst = (u.pn == 3) ? conva : convg;
#pragma unroll
                    for (int bj = 0; bj < 2; ++bj) *(u32x4*)(dst + (size_t)row * 256 + bj * HALF + cl0) = pack8(v[bj][0], v[bj][1]);
                }
            }
    }
};

struct EpiUp {
    static constexpr bool PERM = true, AFTER_DRAIN = false;
    const float* ssq4; float inv_width; bf16* out;
    __device__ __forceinline__ void operator()(const f32x4 (&acc)[2][2][4][2], const Unit& u, int wr, int wc, int fr, int fq) const {
        const int col0 = u.pn * BM + wc * 32 + 8 * fq;
#pragma unroll
        for (int ai = 0; ai < 2; ++ai)
#pragma unroll
            for (int m = 0; m < 4; ++m) {
                const int row = u.pm * BM + ai * HALF + wr * 64 + m * 16 + fr;
                const f32x4 q = *(const f32x4*)(ssq4 + row * 4);
                const float rs = 1.0f / sqrtf(((q[0] + q[1]) + (q[2] + q[3])) * inv_width + EPS);
#pragma unroll
                for (int bj = 0; bj < 2; ++bj) *(u32x4*)(out + (size_t)row * 1024 + col0 + bj * HALF) = pack8(acc[ai][bj][m][0] * rs, acc[ai][bj][m][1] * rs);
            }
    }
};

struct EpiGlu {
    static constexpr bool PERM = true, AFTER_DRAIN = true;
    const bf16* z; bf16* y;
    __device__ __forceinline__ void fused(f32x4 (&acc)[2][2][4][2], const Unit& u, int wr, int wc, int fr, int fq, LAS unsigned char* lds, int wid, int lane) const {
        LAS float* P = (LAS float*)lds;
        const int col0 = wc * 32 + 8 * fq;
#pragma unroll
        for (int ai = 0; ai < 2; ++ai)
#pragma unroll
            for (int m = 0; m < 4; ++m) {
                const int rl = ai * HALF + wr * 64 + m * 16 + fr, row = u.pm * BM + rl;
                float s = 0.f;
#pragma unroll
                for (int bj = 0; bj < 2; ++bj) {
                    const u32x4 zw = *(const u32x4*)(z + (size_t)row * 256 + bj * HALF + col0);
                    const float zf[8] = {bflo(zw.x), bfhi(zw.x), bflo(zw.y), bfhi(zw.y), bflo(zw.z), bfhi(zw.z), bflo(zw.w), bfhi(zw.w)};
#pragma unroll
                    for (int n = 0; n < 2; ++n)
#pragma unroll
                        for (int i = 0; i < 4; ++i) { const float o = zf[n * 4 + i] * sigmoidf_(acc[ai][bj][m][n][i]); acc[ai][bj][m][n][i] = o; s += o * o; }
                }
                s += __shfl_xor(s, 16); s += __shfl_xor(s, 32);
                if (fq == 0) P[rl * 4 + wc] = s;
            }
        asm volatile("s_waitcnt lgkmcnt(0)" ::: "memory"); __builtin_amdgcn_s_barrier(); asm volatile("" ::: "memory");
#pragma unroll
        for (int ai = 0; ai < 2; ++ai)
#pragma unroll
            for (int m = 0; m < 4; ++m) {
                const int rl = ai * HALF + wr * 64 + m * 16 + fr, row = u.pm * BM + rl;
                const f32x4 q = *(const LAS f32x4*)(P + rl * 4);
                const float rs = 1.0f / sqrtf(((q[0] + q[1]) + (q[2] + q[3])) * (1.0f / 256.0f) + EPS);
#pragma unroll
                for (int bj = 0; bj < 2; ++bj) *(u32x4*)(y + (size_t)row * 1024 + 512 + bj * HALF + col0) = pack8(acc[ai][bj][m][0] * rs, acc[ai][bj][m][1] * rs);
            }
        asm volatile("s_waitcnt lgkmcnt(0)" ::: "memory"); __builtin_amdgcn_s_barrier(); asm volatile("" ::: "memory");
    }
};

struct EpiResidual {
    static constexpr bool PERM = false, AFTER_DRAIN = false;
    const float* xin; float* xout;
    __device__ __forceinline__ void operator()(const f32x4 (&acc)[2][2][4][2], const Unit& u, int wr, int wc, int fr, int fq) const {
        const int col0 = u.pn * BM + wc * 32 + 4 * fq;
#pragma unroll
        for (int ai = 0; ai < 2; ++ai)
#pragma unroll
            for (int m = 0; m < 4; ++m) {
                const size_t off = (size_t)(u.pm * BM + ai * HALF + wr * 64 + m * 16 + fr) * 1024 + col0;
#pragma unroll
                for (int bj = 0; bj < 2; ++bj)
#pragma unroll
                    for (int n = 0; n < 2; ++n) { const f32x4 b = *(const f32x4*)(xin + off + bj * HALF + n * 16); *(f32x4*)(xout + off + bj * HALF + n * 16) = b + acc[ai][bj][m][n]; }
            }
    }
};
}

struct MoeSched {
    const LAS int* tab; const int* toklist; int G, c; bool gather;
    __device__ __forceinline__ int expert_of(int pmb) const { return tab[(MISC_BLK - MISC_TAB) / 4 + pmb]; }
    __device__ bool next(int i, pg8::Unit& u) const {
        const int idx = i * G + c, nunits = tab[64] * 4; if (idx >= nunits) return false;
        const int pmb = idx >> 2, j = idx & 3; const int e = expert_of(pmb);
        u.pm = pmb; u.pn = e * 4 + j; return true;
    }
    __device__ __forceinline__ unsigned arow(const pg8::Unit& u, int rloc) const {
        if (!gather) return (unsigned)(u.pm * 256 + rloc);
        const int e = u.pn >> 2; const int s = (u.pm - tab[32 + e]) * 256 + rloc;
        return (s < tab[e]) ? (unsigned)toklist[e * 16384 + s] : 0u;
    }
};
namespace epi {
struct EpiMoe1 {
    static constexpr bool PERM = true, AFTER_DRAIN = false;
    const LAS int* tab; const float* rslist; bf16* H;
    __device__ __forceinline__ void operator()(const f32x4 (&acc)[2][2][4][2], const Unit& u, int wr, int wc, int fr, int fq) const {
        const int e = u.pn >> 2, j = u.pn & 3, cnt = tab[e], s0 = (u.pm - tab[32 + e]) * 256;
#pragma unroll
        for (int ai = 0; ai < 2; ++ai)
#pragma unroll
            for (int m = 0; m < 4; ++m) {
                const int rl = ai * HALF + wr * 64 + m * 16 + fr, s = s0 + rl;
                float rs = 0.f; if (s < cnt) rs = rslist[e * 16384 + s];
                f32x4 o[2];
#pragma unroll
                for (int n = 0; n < 2; ++n)
#pragma unroll
                    for (int i = 0; i < 4; ++i) { const float a = acc[ai][0][m][n][i] * rs, b = acc[ai][1][m][n][i] * rs; o[n][i] = a * sigmoidf_(a) * b; }
                *(u32x4*)(H + (size_t)(u.pm * 256 + rl) * 512 + j * 128 + wc * 32 + 8 * fq) = pack8(o[0], o[1]);
            }
    }
};
struct EpiMoe2 {
    static constexpr bool PERM = true, AFTER_DRAIN = false;
    const LAS int* tab; const float* gatelist; bf16* Y;
    __device__ __forceinline__ void operator()(const f32x4 (&acc)[2][2][4][2], const Unit& u, int wr, int wc, int fr, int fq) const {
        const int e = u.pn >> 2, j = u.pn & 3, cnt = tab[e], s0 = (u.pm - tab[32 + e]) * 256;
        const int col0 = j * 256 + wc * 32 + 8 * fq;
#pragma unroll
        for (int ai = 0; ai < 2; ++ai)
#pragma unroll
            for (int m = 0; m < 4; ++m) {
                const int rl = ai * HALF + wr * 64 + m * 16 + fr, s = s0 + rl;
                float gt = 0.f; if (s < cnt) gt = gatelist[e * 16384 + s];
#pragma unroll
                for (int bj = 0; bj < 2; ++bj) *(u32x4*)(Y + (size_t)(u.pm * 256 + rl) * 1024 + col0 + bj * HALF) = pack8(acc[ai][bj][m][0] * gt, acc[ai][bj][m][1] * gt);
            }
    }
};
}
#define XB_TMO      128
#define XB_XCNT(j)  (256  + 64 * (j))
#define XB_XSUB(j)  (1280 + 64 * (j))
#define XB_XGEN(j)  (2304 + 64 * (j))
#define XB_TOP      3328
#define XB_TOPGEN   3392
#define XCD_BAR_WORDS 3456
#define XB_SPIN_CAP (1u << 18)
__device__ __forceinline__ unsigned xb_ld(unsigned* p)              { return __hip_atomic_load(p, __ATOMIC_RELAXED, __HIP_MEMORY_SCOPE_AGENT); }
__device__ __forceinline__ unsigned xb_add(unsigned* p, unsigned v) { return __hip_atomic_fetch_add(p, v, __ATOMIC_RELAXED, __HIP_MEMORY_SCOPE_AGENT); }
__device__ __forceinline__ unsigned xb_xcc_id() { return (unsigned)__builtin_amdgcn_s_getreg((3 << 11) | 20) & 0xFu; }
#define XB_SPIN(cond, bar) do { unsigned _sp = 0; while (cond) { __builtin_amdgcn_s_sleep(1); \
    if ((++_sp & 255u) == 0u) { if (xb_ld(&(bar)[XB_TMO])) break; if (_sp > XB_SPIN_CAP) { atomicAdd(&(bar)[XB_TMO], 1u); break; } } } } while (0)
struct XcdBarrier { unsigned* bar; unsigned x; volatile LAS unsigned* st; };
__device__ __forceinline__ XcdBarrier xcd_barrier_post(unsigned* bar, volatile LAS unsigned* st) {
    XcdBarrier b; b.bar = bar; b.x = xb_xcc_id(); b.st = st;
    if (threadIdx.x == 0) (void)xb_add(&bar[XB_XCNT(b.x)], 1u);
    return b;
}
__device__ __forceinline__ void xcd_barrier_complete(unsigned* bar, unsigned x, unsigned& nloc, unsigned& nx) {
    const unsigned G = gridDim.x * gridDim.y * gridDim.z;
    unsigned sum, cnt, mine, sp = 0u;
    for (;;) {
        sum = 0u; cnt = 0u; mine = 0u;
#pragma unroll
        for (unsigned j = 0; j < 16; ++j) { const unsigned c = xb_ld(&bar[XB_XCNT(j)]); sum += c; cnt += (c > 0u) ? 1u : 0u; mine = (j == x) ? c : mine; }
        if (sum == G) break;
        __builtin_amdgcn_s_sleep(1);
        if ((++sp & 255u) == 0u) { if (xb_ld(&bar[XB_TMO])) break; if (sp > XB_SPIN_CAP) { atomicAdd(&bar[XB_TMO], 1u); break; } }
    }
    nloc = mine > 0u ? mine : 1u; nx = cnt > 0u ? cnt : 1u;
}
__device__ __forceinline__ void xcd_barrier(const XcdBarrier& b) {
    asm volatile("s_waitcnt vmcnt(0)" ::: "memory");
    __syncthreads();
    if (threadIdx.x == 0) {
        unsigned* bar = b.bar;
        __builtin_amdgcn_s_waitcnt(0);
        unsigned nloc = b.st[0], nx = b.st[1];
        if (nloc == 0u) { xcd_barrier_complete(bar, b.x, nloc, nx); b.st[0] = nloc; b.st[1] = nx; }
        const unsigned old = xb_add(&bar[XB_XSUB(b.x)], 1u);
        const unsigned gen = old / nloc;
        if (old + 1u == (gen + 1u) * nloc) {
            __builtin_amdgcn_fence(__ATOMIC_RELEASE, "agent");
            asm volatile("s_waitcnt vmcnt(0)" ::: "memory");
            const unsigned og = xb_add(&bar[XB_TOP], 1u);
            const unsigned tg = og / nx;
            if (og + 1u == (tg + 1u) * nx) xb_add(&bar[XB_TOPGEN], 1u);
            else XB_SPIN(xb_ld(&bar[XB_TOPGEN]) == tg, bar);
            __builtin_amdgcn_fence(__ATOMIC_ACQUIRE, "agent");
            xb_add(&bar[XB_XGEN(b.x)], 1u);
            asm volatile("s_waitcnt vmcnt(0)" ::: "memory");
        } else {
            XB_SPIN(xb_ld(&bar[XB_XGEN(b.x)]) == gen, bar);
            __builtin_amdgcn_fence(__ATOMIC_ACQUIRE, "agent");
            asm volatile("s_waitcnt vmcnt(0)" ::: "memory");
        }
    }
    __syncthreads();
}

struct Args {
    const float* x; const int* pos; const float* mix_norm; const float* w_in; const float* q_a_norm; const float* w_uq; const float* kv_a_norm; const float* w_ukv;
    const float* q_norm; const float* k_norm; const float* lam_re; const float* lam_im; const float* b_re; const float* b_im; const float* c_re; const float* c_im;
    const float* ssm_d; const float* log_dt; const float* w_glu; const float* dw_w; const float* dw_b; const float* ln_w; const float* ln_b; const float* out_norm;
    const float* w_out; const float* ffn_norm; const float* w_grp; const float* b_grp; const float* w_exp; const float* b_exp; const float* w1; const float* w3; const float* w2;
    float* out; unsigned char* ws;
};
typedef const Args __attribute__((address_space(4))) CArgs;
struct Frame {
    LAS unsigned char* lds; int tid, lane, wave, vcu, G;
};

struct TItem { const float* W; const float* gain; bf16* WT; int ldw, k0, n0, dpitch, dst_row0; };
__device__ __forceinline__ void titem_load(const TItem& t, f32x4 (&v)[8], float (&g)[8], int lane) {
#pragma unroll
    for (int i = 0; i < 8; ++i) { const int kk = i * 8 + (lane >> 3); v[i] = *(const f32x4*)(t.W + (size_t)(t.k0 + kk) * t.ldw + t.n0 + (lane & 7) * 4); g[i] = t.gain ? t.gain[t.k0 + kk] : 1.0f; }
}
__device__ __forceinline__ void titem_store(const TItem& t, const f32x4 (&v)[8], const float (&g)[8], LAS float* scr, int lane) {
#pragma unroll
    for (int i = 0; i < 8; ++i) { const int kk = i * 8 + (lane >> 3); LAS float* d = scr + kk * 33 + (lane & 7) * 4; d[0] = v[i].x * g[i]; d[1] = v[i].y * g[i]; d[2] = v[i].z * g[i]; d[3] = v[i].w * g[i]; }
    asm volatile("s_waitcnt lgkmcnt(0)" ::: "memory");
    const int c = lane & 7;
#pragma unroll
    for (int j = 0; j < 4; ++j) { const int n = (lane >> 3) + 8 * j; const LAS float* s = scr + (8 * c) * 33 + n;
        u32x4 o; o.x = pk2(s[0 * 33], s[1 * 33]); o.y = pk2(s[2 * 33], s[3 * 33]); o.z = pk2(s[4 * 33], s[5 * 33]); o.w = pk2(s[6 * 33], s[7 * 33]);
        *(u32x4*)(t.WT + (size_t)(t.dst_row0 + n) * t.dpitch + t.k0 + 8 * c) = o; }
    asm volatile("s_waitcnt lgkmcnt(0)" ::: "memory");
}

__device__ __forceinline__ void sincos_d(double x, double& s, double& c) {
    const double q = rint(x * 0.63661977236758134308); const int iq = (int)q;
    double r = fma(-q, 1.57079632679489655800, x); r = fma(-q, 6.12323399573676603587e-17, r);
    const double r2 = r * r;
    const double sp = r * (1.0 + r2 * (-1.0 / 6 + r2 * (1.0 / 120 + r2 * (-1.0 / 5040 + r2 * (1.0 / 362880 + r2 * (-1.0 / 39916800 + r2 * (1.0 / 6227020800.0)))))));
    const double cp = 1.0 + r2 * (-0.5 + r2 * (1.0 / 24 + r2 * (-1.0 / 720 + r2 * (1.0 / 40320 + r2 * (-1.0 / 3628800 + r2 * (1.0 / 479001600 + r2 * (-1.0 / 87178291200.0)))))));
    switch (iq & 3) { case 0: s = sp; c = cp; break; case 1: s = cp; c = -sp; break; case 2: s = -sp; c = -cp; break; default: s = -cp; c = sp; break; }
}
__device__ __forceinline__ void ssm_tables(const Frame& F, CArgs& a, int l, int g, int qt) {
    LAS float* PW = (LAS float*)F.lds;
    LAS float* BB = (LAS float*)(F.lds + 33280);
    LAS float* CC = (LAS float*)(F.lds + 41472);
    const int lg = l * SSG + g;
    const double dt = exp((double)a.log_dt[lg]);
    for (int idx = F.tid; idx < 64 * 65; idx += 512) { const int p = idx / 65, d = idx % 65;
        const double re = a.lam_re[lg * 64 + p], im = a.lam_im[lg * 64 + p];
        const double mag = exp(re * dt * d), ang = im * dt * d; double sn, cs; sincos_d(ang, sn, cs);
        PW[idx * 2] = (float)(mag * cs); PW[idx * 2 + 1] = (float)(mag * sn); }
    for (int idx = F.tid; idx < 64 * 16; idx += 512) { const int p = idx >> 4, c = idx & 15;
        const double re = a.lam_re[lg * 64 + p], im = a.lam_im[lg * 64 + p];
        double sn, cs; sincos_d(im * dt, sn, cs);
        const double mag = exp(re * dt), lbr = mag * cs - 1.0, lbi = mag * sn;
        const double den = re * re + im * im; const double fr_ = (lbr * re + lbi * im) / den, fi_ = (lbi * re - lbr * im) / den;
        const double br = a.b_re[((size_t)lg * 64 + p) * 16 + c], bi = a.b_im[((size_t)lg * 64 + p) * 16 + c];
        BB[idx * 2] = (float)(fr_ * br - fi_ * bi); BB[idx * 2 + 1] = (float)(fr_ * bi + fi_ * br); }
    for (int idx = F.tid; idx < 16 * 64; idx += 512) { CC[idx * 2] = a.c_re[(size_t)lg * 1024 + idx]; CC[idx * 2 + 1] = a.c_im[(size_t)lg * 1024 + idx]; }
    __syncthreads();
    unsigned char* tab = a.ws + WS_SSMTAB + (size_t)l * SSMTAB_LAYER;
    bf16* KD = (bf16*)(tab + ST_KD) + (size_t)g * 64 * 256;
    for (int idx = qt * 2048 + F.tid; idx < (qt + 1) * 2048; idx += 512) { const int d = idx >> 8, c = (idx >> 4) & 15, c2 = idx & 15; float s = 0.f;
#pragma unroll 8
        for (int p = 0; p < 64; ++p) { const float cr = CC[(c * 64 + p) * 2], ci = CC[(c * 64 + p) * 2 + 1], pr = PW[(p * 65 + d) * 2], pi = PW[(p * 65 + d) * 2 + 1];
            const float tr = cr * pr - ci * pi, ti = cr * pi + ci * pr; s += tr * BB[(p * 16 + c2) * 2] - ti * BB[(p * 16 + c2) * 2 + 1]; }
        if (d == 0 && c == c2) s += a.ssm_d[lg * 16 + c];
        KD[idx] = (bf16)f2bf(s); }
    bf16* WST = (bf16*)(tab + ST_WST) + (size_t)g * 4 * 64 * 512;
    for (int idx = qt * 16384 + F.tid; idx < (qt + 1) * 16384; idx += 512) { const int jj = idx & 7, ln = (idx >> 3) & 63, ks = (idx >> 9) & 63, rt = idx >> 15;
        const int rho = 32 * rt + (ln & 31), p = rho >> 1, ri = rho & 1, j = ks, c2 = 8 * (ln >> 5) + jj;
        const float pr = PW[(p * 65 + 63 - j) * 2], pi = PW[(p * 65 + 63 - j) * 2 + 1], br = BB[(p * 16 + c2) * 2], bi = BB[(p * 16 + c2) * 2 + 1];
        WST[idx] = (bf16)f2bf(ri ? (pr * bi + pi * br) : (pr * br - pi * bi)); }
    bf16* VIN = (bf16*)(tab + ST_VIN) + (size_t)g * 32 * 8 * 512;
    for (int idx = qt * 16384 + F.tid; idx < (qt + 1) * 16384; idx += 512) { const int jj = idx & 7, ln = (idx >> 3) & 63, ks = (idx >> 9) & 7, rt = idx >> 12;
        const int row = 32 * rt + (ln & 31), i = row >> 4, c = row & 15, k = 16 * ks + 8 * (ln >> 5) + jj, p = k >> 1, ri = k & 1;
        const float cr = CC[(c * 64 + p) * 2], ci = CC[(c * 64 + p) * 2 + 1], pr = PW[(p * 65 + i + 1) * 2], pi = PW[(p * 65 + i + 1) * 2 + 1];
        VIN[idx] = (bf16)f2bf(ri ? -(cr * pi + ci * pr) : (cr * pr - ci * pi)); }
    float* LAM = (float*)(tab + ST_LAM) + g * 128;
    if (qt == 0 && F.tid < 64) { LAM[F.tid * 2] = PW[(F.tid * 65 + 64) * 2]; LAM[F.tid * 2 + 1] = PW[(F.tid * 65 + 64) * 2 + 1]; }
    __syncthreads();
}

constexpr int I_IN = 37 * 16, I_UQ = 24 * 4, I_UKV = 32 * 2, I_GLU = 8 * 4, I_OUT = 32 * 16, I_W1 = 32 * 16 * 16, I_W2 = 32 * 32 * 8;
constexpr int I_LAYER = I_IN + I_UQ + I_UKV + I_GLU + I_OUT + 2 * I_W1 + I_W2;
__device__ __forceinline__ void decode_item(CArgs& a, int it, TItem& t) {
        const int l = it / I_LAYER; int r = it % I_LAYER;
        if (r < I_IN) { const int nb = r / 16, kb = r % 16, n0 = nb * 32;
            t = TItem{a.w_in + (size_t)l * 1024 * INPROJ, a.mix_norm + l * 1024, (bf16*)(a.ws + WS_WIN) + (size_t)l * 1280 * 1024, INPROJ, kb * 64, n0, 1024, n0 < 416 ? n0 : n0 + 96}; return; } r -= I_IN;
        if (r < I_UQ) { const int nb = r / 4, kb = r % 4;
            t = TItem{a.w_uq + (size_t)l * 256 * 768, a.q_a_norm + l * 256, (bf16*)(a.ws + WS_WUQ) + (size_t)l * 1024 * 256, 768, kb * 64, nb * 32, 256, (nb / 3) * 128 + (nb % 3) * 32}; return; } r -= I_UQ;
        if (r < I_UKV) { const int nb = r / 2, kb = r % 2;
            t = TItem{a.w_ukv + (size_t)l * 128 * 1024, a.kv_a_norm + l * 128, (bf16*)(a.ws + WS_WUKV) + (size_t)l * 1024 * 256, 1024, kb * 64, nb * 32, 256, nb * 32}; return; } r -= I_UKV;
        if (r < I_GLU) { const int nb = r / 4, kb = r % 4;
            t = TItem{a.w_glu + (size_t)l * 256 * 256, nullptr, (bf16*)(a.ws + WS_WGLU) + (size_t)l * 256 * 256, 256, kb * 64, nb * 32, 256, nb * 32}; return; } r -= I_GLU;
        if (r < I_OUT) { const int nb = r / 16, kb = r % 16;
            t = TItem{a.w_out + (size_t)l * 1024 * 1024, a.out_norm + l * 1024, (bf16*)(a.ws + WS_WOUT) + (size_t)l * 1024 * 1024, 1024, kb * 64, nb * 32, 1024, nb * 32}; return; } r -= I_OUT;
        if (r < 2 * I_W1) { const int which = r / I_W1; r %= I_W1; const int e = r / 256, q = r % 256, nb = q / 16, kb = q % 16;
            t = TItem{(which ? a.w3 : a.w1) + ((size_t)l * NEXP + e) * 1024 * 512, a.ffn_norm + l * 1024, (bf16*)(a.ws + WS_W13) + (size_t)l * NEXP * 1024 * 1024, 512, kb * 64, nb * 32, 1024,
                      e * 1024 + (nb / 4) * 256 + which * 128 + (nb % 4) * 32}; return; } r -= 2 * I_W1;
        { const int e = r / 256, q = r % 256, nb = q / 8, kb = q % 8;
            t = TItem{a.w2 + ((size_t)l * NEXP + e) * 512 * 1024, nullptr, (bf16*)(a.ws + WS_W2) + (size_t)l * NEXP * 1024 * 512, 1024, kb * 64, nb * 32, 512, e * 1024 + nb * 32}; }
}

__device__ __forceinline__ void phase_prologue(const Frame& F, CArgs& a) {
    for (int task = F.vcu; task < 256; task += F.G) ssm_tables(F, a, task >> 7, (task >> 3) & 15, task & 7);
    LAS float* scr = (LAS float*)(F.lds + F.wave * 16384);
    const int gw = F.vcu * 8 + F.wave, NGW = F.G * 8;
    {
        TItem tc, tn; f32x4 vc[8], vn[8]; float gc[8], gn[8];
        int it = gw;
        if (it < 2 * I_LAYER) { decode_item(a, it, tc); titem_load(tc, vc, gc, F.lane); }
        while (it < 2 * I_LAYER) {
            const int nx = it + NGW; const bool hn = nx < 2 * I_LAYER;
            if (hn) { decode_item(a, nx, tn); titem_load(tn, vn, gn, F.lane); }
            titem_store(tc, vc, gc, scr, F.lane);
            if (hn) { tc = tn;
#pragma unroll
                for (int i = 0; i < 8; ++i) { vc[i] = vn[i]; gc[i] = gn[i]; } }
            it = nx;
        }
    }
    const int gt = F.vcu * 512 + F.tid, NGT = F.G * 512;
    for (int l = 0; l < 2; ++l) {
        u32x4 z4 = (u32x4){0u, 0u, 0u, 0u};
        { u32x4* p = (u32x4*)((bf16*)(a.ws + WS_WIN) + ((size_t)l * 1280 + 416) * 1024); for (int i = gt; i < 96 * 128; i += NGT) p[i] = z4; }
        { bf16* base = (bf16*)(a.ws + WS_WUQ) + (size_t)l * 1024 * 256; for (int i = gt; i < 8 * 32 * 32; i += NGT) { const int h = i >> 10, rr = (i >> 5) & 31, cc = i & 31; *(u32x4*)(base + (size_t)(h * 128 + 96 + rr) * 256 + cc * 8) = z4; } }
        { bf16* base = (bf16*)(a.ws + WS_WUKV) + (size_t)l * 1024 * 256; for (int i = gt; i < 1024 * 16; i += NGT) { const int rr = i >> 4, cc = i & 15; *(u32x4*)(base + (size_t)rr * 256 + 128 + cc * 8) = z4; } }
    }
    for (int i = gt; i < 2 * 1024 * 40; i += NGT) { const int l = i / (1024 * 40), k = (i / 40) % 1024, j = i % 40; float v = 0.f;
        if (j < 4) v = a.w_grp[((size_t)l * 1024 + k) * 4 + j]; else if (j < 36) v = a.w_exp[((size_t)l * 1024 + k) * 32 + (j - 4)];
        ((float*)(a.ws + WS_ROUTER))[i] = v * a.ffn_norm[l * 1024 + k]; }
    for (int i = gt; i < NTOK * 16; i += NGT) { const int t = i >> 4, j = i & 15;
        const float inv = (float)exp(-(double)(2 * j) / 32.0 * 9.210340371976184); const float ang = (float)a.pos[t] * inv;
        double sn, cs; sincos_d((double)ang, sn, cs);
        ((float*)(a.ws + WS_COS))[i] = (float)cs; ((float*)(a.ws + WS_SIN))[i] = (float)sn; }
    for (int m = gw; m < NTOK; m += NGW) {
        const f32x4* xr = (const f32x4*)(a.x + (size_t)m * DM) + F.lane; f32x4 v[4]; float s = 0.f;
#pragma unroll
        for (int j = 0; j < 4; ++j) { v[j] = xr[64 * j]; s += (v[j].x * v[j].x + v[j].y * v[j].y) + (v[j].z * v[j].z + v[j].w * v[j].w); }
        s = wave_sum(s);
        u32x2* o = (u32x2*)((bf16*)(a.ws + WS_XB) + (size_t)m * DM) + F.lane;
#pragma unroll
        for (int j = 0; j < 4; ++j) { u32x2 w; w.x = pk2(v[j].x, v[j].y); w.y = pk2(v[j].z, v[j].w); o[64 * j] = w; }
        if (F.lane == 0) ((float*)(a.ws + WS_SMALL + SM_RSTD1))[m] = 1.0f / sqrtf(s * (1.0f / DM) + EPS);
    }
}
struct PrepRegs { u32x2 lq[3], lk[3], lv[2]; f32x4 cs, sn; };
__device__ __forceinline__ void prep_load(PrepRegs& R, const bf16* qraw, const bf16* kvraw, const bf16* ckv, const float* cosT, const float* sinT, int t, int head, int s) {
#pragma unroll
    for (int i = 0; i < 3; ++i) R.lq[i] = *(const u32x2*)(qraw + (size_t)t * 1024 + head * 128 + 32 * i + 4 * s);
#pragma unroll
    for (int i = 0; i < 2; ++i) { R.lk[i] = *(const u32x2*)(kvraw + (size_t)t * 1024 + head * 128 + 32 * i + 4 * s); R.lv[i] = *(const u32x2*)(kvraw + (size_t)t * 1024 + head * 128 + 64 + 32 * i + 4 * s); }
    R.lk[2] = *(const u32x2*)(ckv + (size_t)t * 256 + 128 + 4 * s);
    R.cs = *(const f32x4*)(cosT + (size_t)t * 16 + 4 * (s & 3)); R.sn = *(const f32x4*)(sinT + (size_t)t * 16 + 4 * (s & 3));
}
__device__ __forceinline__ void prep_norm_rope(f32x4 (&v)[3], const f32x4 (&g)[3], const f32x4 cs, const f32x4 sn, int s) {
    float ss = 0.f;
#pragma unroll
    for (int i = 0; i < 3; ++i) ss += (v[i].x * v[i].x + v[i].y * v[i].y) + (v[i].z * v[i].z + v[i].w * v[i].w);
    ss = sum8(ss);
    const float rs = 1.0f / sqrtf(ss * (1.0f / 96.0f) + EPS);
#pragma unroll
    for (int i = 0; i < 3; ++i) v[i] = v[i] * rs * g[i];
    f32x4 o, pv;
#pragma unroll
    for (int e = 0; e < 4; ++e) pv[e] = __shfl_xor(v[2][e], 4);
#pragma unroll
    for (int e = 0; e < 4; ++e) o[e] = (s < 4) ? (v[2][e] * cs[e] - pv[e] * sn[e]) : (pv[e] * sn[e] + v[2][e] * cs[e]);
    v[2] = o;
}
__device__ __forceinline__ f32x4 unpack4(const u32x2 w) { return (f32x4){bflo(w.x), bfhi(w.x), bflo(w.y), bfhi(w.y)}; }
__device__ __forceinline__ void prep_finish(const PrepRegs& R, const f32x4 (&gqv)[3], const f32x4 (&gkv)[3], bf16* Q, bf16* K, bf16* V, int t, int head, int s) {
    const float QSCALE = 0.10206207261596577f * 1.4426950408889634f;
    f32x4 v[3];
#pragma unroll
    for (int i = 0; i < 3; ++i) v[i] = unpack4(R.lq[i]);
    prep_norm_rope(v, gqv, R.cs, R.sn, s);
#pragma unroll
    for (int i = 0; i < 3; ++i) { u32x2 w; w.x = pk2(v[i].x * QSCALE, v[i].y * QSCALE); w.y = pk2(v[i].z * QSCALE, v[i].w * QSCALE);
        *(u32x2*)(Q + (size_t)t * 768 + head * 96 + 32 * i + 4 * s) = w; }
#pragma unroll
    for (int i = 0; i < 3; ++i) v[i] = unpack4(R.lk[i]);
    prep_norm_rope(v, gkv, R.cs, R.sn, s);
#pragma unroll
    for (int i = 0; i < 3; ++i) { u32x2 w; w.x = pk2(v[i].x, v[i].y); w.y = pk2(v[i].z, v[i].w);
        *(u32x2*)(K + (size_t)t * 768 + head * 96 + 32 * i + 4 * s) = w; }
#pragma unroll
    for (int i = 0; i < 2; ++i) *(u32x2*)(V + (size_t)t * 512 + head * 64 + 32 * i + 4 * s) = R.lv[i];
}
__device__ __forceinline__ void phase_prep(const Frame& F, CArgs& a, int l) {
    const bf16* qraw = (const bf16*)(a.ws + WS_QRAW); const bf16* kvraw = (const bf16*)(a.ws + WS_KVRAW); const bf16* ckv = (const bf16*)(a.ws + WS_CKV);
    bf16* Q = (bf16*)(a.ws + WS_Q); bf16* K = (bf16*)(a.ws + WS_K); bf16* V = (bf16*)(a.ws + WS_V);
    const float* cosT = (const float*)(a.ws + WS_COS); const float* sinT = (const float*)(a.ws + WS_SIN);
    const float* gq = a.q_norm + l * QKH; const float* gk = a.k_norm + l * QKH;
    const int lane = F.lane, head = lane >> 3, s = lane & 7;
    f32x4 gqv[3], gkv[3];
#pragma unroll
    for (int i = 0; i < 3; ++i) { gqv[i] = *(const f32x4*)(gq + 32 * i + 4 * s); gkv[i] = *(const f32x4*)(gk + 32 * i + 4 * s); }
    const int gw = F.vcu * 8 + F.wave, NGW = F.G * 8;
    for (int t = gw; t < NTOK; t += 2 * NGW) {
        PrepRegs R0, R1;
        prep_load(R0, qraw, kvraw, ckv, cosT, sinT, t, head, s);
        const bool two = (t + NGW) < NTOK;
        if (two) prep_load(R1, qraw, kvraw, ckv, cosT, sinT, t + NGW, head, s);
        prep_finish(R0, gqv, gkv, Q, K, V, t, head, s);
        if (two) prep_finish(R1, gqv, gkv, Q, K, V, t + NGW, head, s);
    }
}

__device__ __forceinline__ void conv_unit(const Frame& F, CArgs& a, int l, int unit) {
    LAS float* UL = (LAS float*)F.lds;
    LAS float* WL = (LAS float*)(F.lds + 94 * 256 * 4);
    const bf16* ca = (const bf16*)(a.ws + WS_CONVA); const bf16* cg = (const bf16*)(a.ws + WS_CONVG); bf16* Y = (bf16*)(a.ws + WS_Y);
    const int b = unit >> 5, t0 = (unit & 31) * 64;
    __syncthreads();
    {
      const size_t base = ((size_t)(b * SEQ + t0 - 30 + F.wave)) * 256 + F.lane * 4;
      LAS float* ub = UL + F.wave * 256 + F.lane * 4;
#pragma nounroll
      for (int hb = 0; hb < 2; ++hb) { u32x2 wa[6], wg[6];
#pragma unroll
        for (int i = 0; i < 6; ++i) { const int r = F.wave + 8 * (6 * hb + i); wa[i] = (u32x2){0u, 0u}; wg[i] = (u32x2){0u, 0u};
            if (r < 94 && t0 - 30 + r >= 0) { wa[i] = *(const u32x2*)(ca + base + (size_t)(6 * hb + i) * 8 * 256); wg[i] = *(const u32x2*)(cg + base + (size_t)(6 * hb + i) * 8 * 256); } }
#pragma unroll
        for (int i = 0; i < 6; ++i) { const int r = F.wave + 8 * (6 * hb + i);
            if (r < 94) { f32x4 u;
                u.x = bflo(wa[i].x) * sigmoidf_(bflo(wg[i].x)); u.y = bfhi(wa[i].x) * sigmoidf_(bfhi(wg[i].x)); u.z = bflo(wa[i].y) * sigmoidf_(bflo(wg[i].y)); u.w = bfhi(wa[i].y) * sigmoidf_(bfhi(wg[i].y));
                *(LAS f32x4*)(ub + (6 * hb + i) * 8 * 256) = u; } } } }
    { f32x4 wt[4];
#pragma unroll
      for (int i = 0; i < 4; ++i) { const int idx = F.tid + 512 * i; if (idx < 31 * 64) wt[i] = *(const f32x4*)(a.dw_w + (size_t)l * 31 * 256 + idx * 4); }
#pragma unroll
      for (int i = 0; i < 4; ++i) { const int idx = F.tid + 512 * i; if (idx < 31 * 64) *(LAS f32x4*)(WL + idx * 4) = wt[i]; } }
    __syncthreads();
    const int c0 = F.lane * 4;
    const f32x4 bias = *(const f32x4*)(a.dw_b + l * 256 + c0), lw = *(const f32x4*)(a.ln_w + l * 256 + c0), lb = *(const f32x4*)(a.ln_b + l * 256 + c0);
#pragma nounroll
    for (int tg = 0; tg < 2; ++tg) { const int tok = F.wave * 8 + tg * 4;
        f32x4 acc[4];
#pragma unroll
        for (int q = 0; q < 4; ++q) acc[q] = bias;
        const LAS float* up = UL + tok * 256 + c0; const LAS float* wp = WL + c0;
#pragma unroll
        for (int k = 0; k < 34; ++k) {
            const f32x4 uv = *(const LAS f32x4*)(up + k * 256);
#pragma unroll
            for (int q = 0; q < 4; ++q) { const int tap = k - q; if (tap >= 0 && tap < 31) acc[q] += *(const LAS f32x4*)(wp + tap * 256) * uv; }
        }
        float s1[4], s2[4];
#pragma unroll
        for (int q = 0; q < 4; ++q) { s1[q] = (acc[q].x + acc[q].y) + (acc[q].z + acc[q].w); s2[q] = (acc[q].x * acc[q].x + acc[q].y * acc[q].y) + (acc[q].z * acc[q].z + acc[q].w * acc[q].w); }
#pragma unroll
        for (int q = 0; q < 4; ++q) { s1[q] = wave_sum(s1[q]); s2[q] = wave_sum(s2[q]); }
        f32x4 yv[4]; float ms[4];
#pragma unroll
        for (int q = 0; q < 4; ++q) { const float mean = s1[q] * (1.0f / 256.0f), var = fmaxf(s2[q] * (1.0f / 256.0f) - mean * mean, 0.f), rstd = 1.0f / sqrtf(var + 1e-5f);
            yv[q] = (acc[q] - mean) * rstd * lw + lb;
#pragma unroll
            for (int e = 0; e < 4; ++e) yv[q][e] = yv[q][e] * sigmoidf_(yv[q][e]);
            ms[q] = (yv[q].x * yv[q].x + yv[q].y * yv[q].y) + (yv[q].z * yv[q].z + yv[q].w * yv[q].w); }
#pragma unroll
        for (int q = 0; q < 4; ++q) ms[q] = wave_sum(ms[q]);
#pragma unroll
        for (int q = 0; q < 4; ++q) { const float rr = 1.0f / sqrtf(ms[q] * (1.0f / 256.0f) + EPS);
            u32x2 w; w.x = pk2(yv[q].x * rr, yv[q].y * rr); w.y = pk2(yv[q].z * rr, yv[q].w * rr);
            *(u32x2*)(Y + ((size_t)(b * SEQ + t0 + tok + q)) * 1024 + 768 + c0) = w; } }
    __syncthreads();
}

__device__ __forceinline__ void ssm_unit(const Frame& F, CArgs& a, int l, int unit) {
    const int b = unit >> 4, g = unit & 15;
    LAS unsigned char* KDL = F.lds;
    LAS unsigned char* UL = F.lds + 32768;
    LAS float* SP = (LAS float*)(F.lds + 98304);
    LAS float* SS = (LAS float*)(F.lds + 114688);
    LAS unsigned char* XIN = F.lds + 98304;
    const unsigned char* tab = a.ws + WS_SSMTAB + (size_t)l * SSMTAB_LAYER;
    const bf16* KD = (const bf16*)(tab + ST_KD) + (size_t)g * 64 * 256;
    const bf16* WST = (const bf16*)(tab + ST_WST) + (size_t)g * 4 * 64 * 512;
    const bf16* VIN = (const bf16*)(tab + ST_VIN) + (size_t)g * 32 * 8 * 512;
    const float* LAM = (const float*)(tab + ST_LAM) + g * 128;
    const bf16* U = (const bf16*)(a.ws + WS_USSM) + (size_t)(b * 16 + g) * 64 * 512;
    bf16* Z = (bf16*)(a.ws + WS_Z);
    const int lane = F.lane, w = F.wave, r32 = lane & 31, hi = lane >> 5;
    __syncthreads();
    { u32x4 t0[4], t1[8];
#pragma unroll
      for (int i = 0; i < 4; ++i) t0[i] = *(const u32x4*)((const unsigned char*)KD + (F.tid + 512 * i) * 16);
#pragma unroll
      for (int i = 0; i < 8; ++i) t1[i] = *(const u32x4*)((const unsigned char*)U + (F.tid + 512 * i) * 16);
#pragma unroll
      for (int i = 0; i < 4; ++i) *(LAS u32x4*)(KDL + (F.tid + 512 * i) * 16) = t0[i];
#pragma unroll
      for (int i = 0; i < 8; ++i) *(LAS u32x4*)(UL + (F.tid + 512 * i) * 16) = t1[i]; }
    const int rt4 = w & 3, kh = w >> 2;
    const bf16* wst_w = WST + ((size_t)(rt4 * 64 + kh * 32) * 64 + lane) * 8;
    __syncthreads();
    f32x16 acc[4];
#pragma unroll
    for (int q = 0; q < 4; ++q) acc[q] = (f32x16){};
    const int isub = r32 >> 4, cc = r32 & 15;
    const LAS unsigned char* ufp = UL + r32 * 32 + hi * 16;
#pragma unroll
    for (int q = 0; q < 4; ++q) { const int rt = w + 8 * q, nj = 2 * rt + 2;
        const LAS unsigned char* kp = KDL + (((2 * rt + isub) * 16 + cc) * 16 + 8 * hi) * 2;
#pragma unroll 2
        for (int j = 0; j < nj; j += 2) {
            const bf16x8 u0 = *(const LAS bf16x8*)(ufp + j * 1024), u1 = *(const LAS bf16x8*)(ufp + (j + 1) * 1024);
            bf16x8 a0 = (bf16x8){0, 0, 0, 0, 0, 0, 0, 0}, a1 = a0;
            if (2 * rt + isub - j >= 0) a0 = *(const LAS bf16x8*)(kp - j * 512);
            if (2 * rt + isub - j - 1 >= 0) a1 = *(const LAS bf16x8*)(kp - (j + 1) * 512);
            acc[q] = __builtin_amdgcn_mfma_f32_32x32x16_bf16(a0, u0, acc[q], 0, 0, 0);
            acc[q] = __builtin_amdgcn_mfma_f32_32x32x16_bf16(a1, u1, acc[q], 0, 0, 0); } }
    {
        f32x16 sacc = (f32x16){};
        bf16x8 afA[8], afB[8];
#define SSM_LDW(dst, k8) do { _Pragma("unroll") for (int i = 0; i < 8; ++i) dst[i] = *(const bf16x8*)(wst_w + (size_t)((k8) * 8 + i) * 512); } while (0)
#define SSM_MMW(src, k8) do { _Pragma("unroll") for (int i = 0; i < 8; ++i) { const bf16x8 uf = *(const LAS bf16x8*)(ufp + (kh * 32 + (k8) * 8 + i) * 1024); \
            sacc = __builtin_amdgcn_mfma_f32_32x32x16_bf16(src[i], uf, sacc, 0, 0, 0); } } while (0)
        SSM_LDW(afA, 0); SSM_LDW(afB, 1); SSM_MMW(afA, 0); SSM_LDW(afA, 2); SSM_MMW(afB, 1); SSM_LDW(afB, 3); SSM_MMW(afA, 2); SSM_MMW(afB, 3);
#undef SSM_LDW
#undef SSM_MMW
        if (kh == 1) {
#pragma unroll
            for (int r = 0; r < 16; ++r) SP[(32 * rt4 + (r & 3) + 8 * (r >> 2) + 4 * hi) * 32 + r32] = sacc[r]; }
        __syncthreads();
        if (kh == 0) {
#pragma unroll
            for (int r = 0; r < 16; ++r) { const int o = (32 * rt4 + (r & 3) + 8 * (r >> 2) + 4 * hi) * 32 + r32; SS[o] = sacc[r] + SP[o]; } }
        __syncthreads();
    }
    if (F.tid < 64) { const int p = F.tid; const float lr = LAM[2 * p], li = LAM[2 * p + 1]; float sr = 0.f, si = 0.f;
#pragma unroll 8
        for (int n = 0; n < 32; ++n) {
            *(LAS unsigned*)(XIN + n * 272 + p * 4) = pk2(sr, si);
            const float ar = SS[(2 * p) * 32 + n], ai = SS[(2 * p + 1) * 32 + n];
            const float nr = lr * sr - li * si + ar, ni = lr * si + li * sr + ai; sr = nr; si = ni; } }
    __syncthreads();
    {
        bf16x8 afA[8], afB[8];
#define SSM_LDV(dst, q) do { _Pragma("unroll") for (int ks = 0; ks < 8; ++ks) dst[ks] = *(const bf16x8*)(VIN + ((size_t)((w + 8 * (q)) * 8 + ks) * 64 + lane) * 8); } while (0)
#define SSM_MMV(src, q) do { _Pragma("unroll") for (int ks = 0; ks < 8; ++ks) { const bf16x8 xf = *(const LAS bf16x8*)(XIN + r32 * 272 + (16 * ks + 8 * hi) * 2); \
            acc[q] = __builtin_amdgcn_mfma_f32_32x32x16_bf16(src[ks], xf, acc[q], 0, 0, 0); } } while (0)
        SSM_LDV(afA, 0); SSM_LDV(afB, 1); SSM_MMV(afA, 0); SSM_LDV(afA, 2); SSM_MMV(afB, 1); SSM_LDV(afB, 3); SSM_MMV(afA, 2); SSM_MMV(afB, 3);
#undef SSM_LDV
#undef SSM_MMV
    }
#pragma unroll
    for (int q = 0; q < 4; ++q) { const int rt = w + 8 * q;
#pragma unroll
        for (int rq = 0; rq < 4; ++rq) { const int rowp = 8 * rq + 4 * hi, i = 2 * rt + (rowp >> 4), c0 = rowp & 15;
            u32x2 wv; wv.x = pk2(gelu_tanh(acc[q][4 * rq]), gelu_tanh(acc[q][4 * rq + 1])); wv.y = pk2(gelu_tanh(acc[q][4 * rq + 2]), gelu_tanh(acc[q][4 * rq + 3]));
            *(u32x2*)(Z + ((size_t)(b * SEQ + r32 * 64 + i)) * 256 + g * 16 + c0) = wv; } }
    __syncthreads();
}
typedef short v4i16_t __attribute__((ext_vector_type(4)));
__device__ __forceinline__ s16x4 vtr(const LAS unsigned char* p) { return __builtin_bit_cast(s16x4, __builtin_amdgcn_ds_read_tr16_b64_v4i16((LAS v4i16_t*)p)); }
__device__ __forceinline__ int crow(int r, int hi) { return (r & 3) + 8 * (r >> 2) + 4 * hi; }
constexpr int AT_K = 0, AT_KSLOT = 12288, AT_V = 24576, AT_VSLOT = 8192, AT_WSF = 40960, AT_OST = 43008;
__device__ __forceinline__ void attn_unit(const Frame& F, CArgs& a, int b, int h, int qb) {
    const bf16* Q = (const bf16*)(a.ws + WS_Q); const bf16* K = (const bf16*)(a.ws + WS_K); const bf16* V = (const bf16*)(a.ws + WS_V);
    bf16* Y = (bf16*)(a.ws + WS_Y); float* ssqo = (float*)(a.ws + WS_SMALL + SM_SSQO);
    const int lane = F.lane, w = F.wave, r32 = lane & 31, hi = lane >> 5;
    const int NT = 4 * qb + 4, NTw = 4 * qb + (w >> 1) + 1;
    const size_t rowbase = (size_t)b * SEQ;
    const bf16* Kh = K + rowbase * 768 + h * 96; const bf16* Vh = V + rowbase * 512 + h * 64;
    LAS float* wsf = (LAS float*)(F.lds + AT_WSF) + w * 64;
    bf16x8 qr[6];
    { const bf16* Qw = Q + (rowbase + qb * 256 + w * 32 + r32) * 768 + h * 96 + 8 * hi;
#pragma unroll
      for (int d0 = 0; d0 < 6; ++d0) qr[d0] = *(const bf16x8*)(Qw + 16 * d0); }
    const bf16* ksrc0 = Kh + (size_t)lane * 768 + 8 * w;
    const bf16* ksrc1 = Kh + (size_t)lane * 768 + 8 * (8 + (w & 3));
    const bf16* vsrc = Vh + (size_t)(16 * (w & 3) + (lane >> 2)) * 512 + (w >> 2) * 32 + (lane & 3) * 8;
#define AT_ISSUE(t, s) do { \
        __builtin_amdgcn_global_load_lds((const unsigned*)(ksrc0 + (size_t)(t) * 64 * 768), (LAS unsigned*)(F.lds + AT_K + (s) * AT_KSLOT + w * 1024), 16, 0, 0); \
        if (w < 4) __builtin_amdgcn_global_load_lds((const unsigned*)(ksrc1 + (size_t)(t) * 64 * 768), (LAS unsigned*)(F.lds + AT_K + (s) * AT_KSLOT + (8 + w) * 1024), 16, 0, 0); \
        __builtin_amdgcn_global_load_lds((const unsigned*)(vsrc + (size_t)(t) * 64 * 512), (LAS unsigned*)(F.lds + AT_V + (s) * AT_VSLOT + w * 1024), 16, 0, 0); } while (0)
    float m_run = -1e30f, l_run = 0.f; f32x16 o0 = (f32x16){}, o1 = (f32x16){};
    __syncthreads();
    AT_ISSUE(0, 0);
    asm volatile("s_waitcnt vmcnt(0)" ::: "memory"); __syncthreads();
    for (int t = 0; t < NT; ++t) {
        const int s = t & 1;
        if (t + 1 < NT) AT_ISSUE(t + 1, s ^ 1);
        if (t < NTw) {
            const LAS unsigned char* kb = F.lds + AT_K + s * AT_KSLOT + hi * 1024 + r32 * 16;
            f32x16 p0 = (f32x16){}, p1 = (f32x16){};
#pragma unroll
            for (int d0 = 0; d0 < 6; ++d0) {
                const bf16x8 k0 = *(const LAS bf16x8*)(kb + d0 * 2048), k1 = *(const LAS bf16x8*)(kb + d0 * 2048 + 512);
                p0 = __builtin_amdgcn_mfma_f32_32x32x16_bf16(k0, qr[d0], p0, 0, 0, 0);
                p1 = __builtin_amdgcn_mfma_f32_32x32x16_bf16(k1, qr[d0], p1, 0, 0, 0); }
            float ra = fmaxf(fmaxf(p0[0], p0[1]), p1[0]), rb_ = fmaxf(fmaxf(p0[2], p0[3]), p1[1]); ra = fmaxf(fmaxf(ra, p1[2]), p1[3]);
#pragma unroll
            for (int r = 4; r < 16; r += 4) { ra = fmaxf(fmaxf(ra, p0[r]), p0[r + 1]); rb_ = fmaxf(fmaxf(rb_, p0[r + 2]), p0[r + 3]); ra = fmaxf(fmaxf(ra, p1[r]), p1[r + 1]); rb_ = fmaxf(fmaxf(rb_, p1[r + 2]), p1[r + 3]); }
            float rm = fmaxf(ra, rb_);
            rm = fmaxf(rm, __shfl_xor(rm, 32));
            if (__any(rm > m_run + 8.0f)) {
                const float mn = fmaxf(m_run, rm), alpha = __builtin_amdgcn_exp2f(m_run - mn); m_run = mn; l_run *= alpha;
                if (hi == 0) wsf[r32] = alpha;
#pragma unroll
                for (int r = 0; r < 16; ++r) { const float f = wsf[crow(r, hi)]; o0[r] *= f; o1[r] *= f; }
            }
            float sl = 0.f;
#pragma unroll
            for (int r = 0; r < 16; ++r) { p0[r] = __builtin_amdgcn_exp2f(p0[r] - m_run); p1[r] = __builtin_amdgcn_exp2f(p1[r] - m_run); sl += p0[r] + p1[r]; }
            l_run += sl;
            bf16x8 pa[4];
#pragma unroll
            for (int ks = 0; ks < 4; ++ks) { u32x4 pw;
#pragma unroll
                for (int e = 0; e < 4; ++e) { const int r = (ks & 1) * 8 + 2 * e; pw[e] = (ks < 2) ? pk2(p0[r], p0[r + 1]) : pk2(p1[r], p1[r + 1]); }
                pa[ks] = __builtin_bit_cast(bf16x8, pw); }
            const LAS unsigned char* vb = F.lds + AT_V + s * AT_VSLOT + ((lane >> 4) & 1) * 32 + (lane & 3) * 8 + (4 * hi + ((lane & 15) >> 2)) * 64;
#pragma unroll
            for (int kg = 0; kg < 4; ++kg) {
                const s16x4 l0 = vtr(vb + kg * 1024), h0 = vtr(vb + kg * 1024 + 512), l1 = vtr(vb + 4096 + kg * 1024), h1 = vtr(vb + 4096 + kg * 1024 + 512);
                const bf16x8 v0 = (bf16x8){l0[0], l0[1], l0[2], l0[3], h0[0], h0[1], h0[2], h0[3]}, v1 = (bf16x8){l1[0], l1[1], l1[2], l1[3], h1[0], h1[1], h1[2], h1[3]};
                o0 = __builtin_amdgcn_mfma_f32_32x32x16_bf16(pa[kg], v0, o0, 0, 0, 0);
                o1 = __builtin_amdgcn_mfma_f32_32x32x16_bf16(pa[kg], v1, o1, 0, 0, 0); }
        }
        asm volatile("s_waitcnt vmcnt(0)" ::: "memory"); __syncthreads();
    }
#undef AT_ISSUE
    l_run += __shfl_xor(l_run, 32);
    if (hi == 0) wsf[32 + r32] = l_run;
    LAS bf16* stg = (LAS bf16*)(F.lds + AT_OST) + w * 2048;
#pragma unroll
    for (int r = 0; r < 16; ++r) { const int orow = crow(r, hi); const float rl = 1.0f / wsf[32 + orow];
        stg[orow * 64 + r32] = (bf16)f2bf(o0[r] * rl); stg[orow * 64 + 32 + r32] = (bf16)f2bf(o1[r] * rl); }
    asm volatile("s_waitcnt lgkmcnt(0)" ::: "memory");
#pragma unroll
    for (int i = 0; i < 4; ++i) { const int row = i * 8 + (lane >> 3), ch = lane & 7; const u32x4 v = *(const LAS u32x4*)(stg + row * 64 + ch * 8);
        const size_t tok = rowbase + qb * 256 + w * 32 + row;
        *(u32x4*)(Y + tok * 1024 + h * 64 + ch * 8) = v;
        float q = bflo(v.x) * bflo(v.x) + bfhi(v.x) * bfhi(v.x) + bflo(v.y) * bflo(v.y) + bfhi(v.y) * bfhi(v.y) + bflo(v.z) * bflo(v.z) + bfhi(v.z) * bfhi(v.z) + bflo(v.w) * bflo(v.w) + bfhi(v.w) * bfhi(v.w);
        q = sum8(q);
        if (ch == 0) ssqo[tok * 8 + h] = q; }
    __syncthreads();
}

constexpr int RT_XS = 0, RT_WS = 33024, RT_PART = 0, RT_LG = 8 * 64 * 37 * 4, RT_SSQ = RT_LG + 64 * 36 * 4, RT_CNT = RT_SSQ + 256, RT_BASE = RT_CNT + 128;
__device__ __forceinline__ void phase_router(const Frame& F, CArgs& a, int l, int dry) {
    LAS float* XS = (LAS float*)(F.lds + RT_XS);
    LAS float* WSL = (LAS float*)(F.lds + RT_WS);
    LAS float* PART = (LAS float*)(F.lds + RT_PART);
    LAS float* LG = (LAS float*)(F.lds + RT_LG);
    LAS float* SSQ = (LAS float*)(F.lds + RT_SSQ);
    LAS int* CNT = (LAS int*)(F.lds + RT_CNT); LAS int* BASE = (LAS int*)(F.lds + RT_BASE);
    const float* RT = (const float*)(a.ws + WS_ROUTER) + (size_t)l * 1024 * 40;
    const float* xres = a.out; bf16* XB = (bf16*)(a.ws + WS_XB);
    unsigned* counts = (unsigned*)(a.ws + WS_CTL) + CW_CNT + l * 32;
    int* toklist = (int*)(a.ws + WS_TOKLIST); float* gatelist = (float*)(a.ws + WS_GATELIST); int* tokslot = (int*)(a.ws + WS_SMALL + SM_TOKSLOT);
    float* rstd2 = (float*)(a.ws + WS_SMALL + SM_RSTD2); float* rslist = (float*)(a.ws + WS_SMALL + SM_RSLIST);
    const int w = F.wave, lane = F.lane;
    for (int tile = F.vcu; tile < NTOK / 64; tile += F.G) {
        const int tok0 = tile * 64;
        float acc[37];
#pragma unroll
        for (int j = 0; j < 37; ++j) acc[j] = 0.f;
        f32x4 xv[4], wv[3];
#define RT_LOAD(kc) do { _Pragma("unroll") for (int i = 0; i < 4; ++i) { const int idx = F.tid + 512 * i, row = idx >> 5, c4 = idx & 31; \
                xv[i] = *(const f32x4*)(xres + (size_t)(tok0 + row) * 1024 + (kc) * 128 + c4 * 4); } \
            _Pragma("unroll") for (int i = 0; i < 3; ++i) { const int idx = F.tid + 512 * i; if (idx < 1280) wv[i] = *(const f32x4*)(RT + (size_t)(kc) * 128 * 40 + idx * 4); } } while (0)
        RT_LOAD(0);
        for (int kc = 0; kc < 8; ++kc) {
            __syncthreads();
#pragma unroll
            for (int i = 0; i < 4; ++i) { const int idx = F.tid + 512 * i, row = idx >> 5, c4 = idx & 31;
                LAS float* d = XS + row * 129 + c4 * 4; d[0] = xv[i].x; d[1] = xv[i].y; d[2] = xv[i].z; d[3] = xv[i].w;
                u32x2 wb; wb.x = pk2(xv[i].x, xv[i].y); wb.y = pk2(xv[i].z, xv[i].w); *(u32x2*)(XB + (size_t)(tok0 + row) * 1024 + kc * 128 + c4 * 4) = wb; }
#pragma unroll
            for (int i = 0; i < 3; ++i) { const int idx = F.tid + 512 * i; if (idx < 1280) *(LAS f32x4*)(WSL + idx * 4) = wv[i]; }
            __syncthreads();
            if (kc + 1 < 8) RT_LOAD(kc + 1);
#pragma unroll 4
            for (int kk = 0; kk < 16; ++kk) { const float x = XS[lane * 129 + 16 * w + kk]; const LAS float* wr_ = WSL + (16 * w + kk) * 40;
#pragma unroll
                for (int j4 = 0; j4 < 9; ++j4) { const f32x4 wq = *(const LAS f32x4*)(wr_ + 4 * j4); acc[4 * j4] += x * wq.x; acc[4 * j4 + 1] += x * wq.y; acc[4 * j4 + 2] += x * wq.z; acc[4 * j4 + 3] += x * wq.w; }
                acc[36] += x * x; }
        }
#undef RT_LOAD
        __syncthreads();
        if (F.tid < 32) CNT[F.tid] = 0;
#pragma unroll
        for (int j = 0; j < 37; ++j) PART[(w * 64 + lane) * 37 + j] = acc[j];
        __syncthreads();
        { const int tok = F.tid & 63, jg = F.tid >> 6;
            for (int j = jg; j < 37; j += 8) { float s = 0.f;
#pragma unroll
                for (int ww = 0; ww < 8; ++ww) s += PART[(ww * 64 + tok) * 37 + j];
                if (j < 36) LG[tok * 36 + j] = s; else SSQ[tok] = s; } }
        __syncthreads();
        int e_sel[2] = {0, 0}, rank[2] = {0, 0}; float gate[2] = {0.f, 0.f}; float rs_tok = 0.f;
        if (F.tid < 64) { const int tok = F.tid; const float rs = 1.0f / sqrtf(SSQ[tok] * (1.0f / 1024.0f) + EPS);
            rstd2[tok0 + tok] = rs; rs_tok = rs;
            float lg[4];
#pragma unroll
            for (int j = 0; j < 4; ++j) lg[j] = rs * LG[tok * 36 + j] + a.b_grp[l * 4 + j];
            int gs = 0; float gm = lg[0];
#pragma unroll
            for (int j = 1; j < 4; ++j) if (lg[j] > gm) { gm = lg[j]; gs = j; }
            float den = 0.f;
#pragma unroll
            for (int j = 0; j < 4; ++j) den += __expf(lg[j] - gm);
            const float pg = 1.0f / den;
            float le[8];
#pragma unroll
            for (int i = 0; i < 8; ++i) le[i] = rs * LG[tok * 36 + 4 + 8 * gs + i] + a.b_exp[l * 32 + 8 * gs + i];
            int i1 = 0; float v1 = le[0];
#pragma unroll
            for (int i = 1; i < 8; ++i) if (le[i] > v1) { v1 = le[i]; i1 = i; }
            int i2 = -1; float v2 = -3.0e38f;
#pragma unroll
            for (int i = 0; i < 8; ++i) if (i != i1 && le[i] > v2) { v2 = le[i]; i2 = i; }
            const float ex = __expf(v2 - v1), p1 = 1.0f / (1.0f + ex), p2 = ex * p1;
            e_sel[0] = 8 * gs + i1; e_sel[1] = 8 * gs + i2; gate[0] = pg * p1; gate[1] = pg * p2;
            rank[0] = __hip_atomic_fetch_add(CNT + e_sel[0], 1, __ATOMIC_RELAXED, __HIP_MEMORY_SCOPE_WORKGROUP);
            rank[1] = __hip_atomic_fetch_add(CNT + e_sel[1], 1, __ATOMIC_RELAXED, __HIP_MEMORY_SCOPE_WORKGROUP); }
        __syncthreads();
        if (F.tid < 32) { const int c = CNT[F.tid]; BASE[F.tid] = (c && !dry) ? (int)__hip_atomic_fetch_add(counts + F.tid, (unsigned)c, __ATOMIC_RELAXED, __HIP_MEMORY_SCOPE_AGENT) : 0; }
        __syncthreads();
        if (F.tid < 64 && !dry) {
#pragma unroll
            for (int k = 0; k < 2; ++k) { const int e = e_sel[k], slot = BASE[e] + rank[k];
                toklist[e * 16384 + slot] = tok0 + F.tid; gatelist[e * 16384 + slot] = gate[k]; rslist[e * 16384 + slot] = rs_tok; tokslot[(tok0 + F.tid) * 2 + k] = e * 16384 + slot; } }
    }
    __syncthreads();
}

__device__ __forceinline__ void moe_tables(const Frame& F, CArgs& a, int l) {
    LAS int* tab = (LAS int*)(F.lds + MISC_TAB);
    unsigned* counts = (unsigned*)(a.ws + WS_CTL) + CW_CNT + l * 32;
    __syncthreads();
    if (F.tid < 32) tab[F.tid] = (int)__hip_atomic_load(counts + F.tid, __ATOMIC_RELAXED, __HIP_MEMORY_SCOPE_AGENT);
    __syncthreads();
    if (F.tid == 0) { int s = 0; for (int e = 0; e < 32; ++e) { tab[32 + e] = s; s += (tab[e] + 255) >> 8; } tab[64] = s; }
    __syncthreads();
    if (F.tid < 192) { int e = 0;
#pragma unroll
        for (int k = 1; k < 32; ++k) e += (tab[32 + k] <= F.tid) ? 1 : 0;
        ((LAS int*)(F.lds + MISC_BLK))[F.tid] = e; }
    __syncthreads();
}

__device__ __forceinline__ void phase_combine(const Frame& F, CArgs& a, int l, int dry) {
    const LAS int* tab = (const LAS int*)(F.lds + MISC_TAB);
    const int* tokslot = (const int*)(a.ws + WS_SMALL + SM_TOKSLOT); const bf16* YR = (const bf16*)(a.ws + WS_YROWS);
    float* xres = a.out; bf16* XB = (bf16*)(a.ws + WS_XB); float* rstd1 = (float*)(a.ws + WS_SMALL + SM_RSTD1);
    float* xdst = dry ? (float*)(a.ws + WS_USSM) : a.out;
    const int gw = F.vcu * 8 + F.wave, NGW = F.G * 8;
    for (int tb = gw; tb < NTOK; tb += 2 * NGW) {
        int tt[2]; u32x2 yv[2][2][4]; f32x4 v[2][4];
#pragma unroll
        for (int q = 0; q < 2; ++q) { const int t = tb + q * NGW; tt[q] = t;
            const int s0 = tokslot[t * 2], s1 = tokslot[t * 2 + 1];
            const size_t r0 = (size_t)tab[32 + (s0 >> 14)] * 256 + (s0 & 16383), r1 = (size_t)tab[32 + (s1 >> 14)] * 256 + (s1 & 16383);
            const f32x4* xr = (const f32x4*)(xres + (size_t)t * 1024) + F.lane; const u32x2* y0 = (const u32x2*)(YR + r0 * 1024) + F.lane; const u32x2* y1 = (const u32x2*)(YR + r1 * 1024) + F.lane;
#pragma unroll
            for (int j = 0; j < 4; ++j) { v[q][j] = xr[64 * j]; yv[q][0][j] = y0[64 * j]; yv[q][1][j] = y1[64 * j]; } }
#pragma unroll
        for (int q = 0; q < 2; ++q) { const int t = tt[q]; float ss = 0.f; f32x4* xw = (f32x4*)(xdst + (size_t)(dry ? (t & 4095) : t) * 1024) + F.lane;
#pragma unroll
            for (int j = 0; j < 4; ++j) { const u32x2 p = yv[q][0][j], r = yv[q][1][j]; f32x4 o = v[q][j];
                o.x = (o.x + bflo(p.x)) + bflo(r.x); o.y = (o.y + bfhi(p.x)) + bfhi(r.x); o.z = (o.z + bflo(p.y)) + bflo(r.y); o.w = (o.w + bfhi(p.y)) + bfhi(r.y);
                xw[64 * j] = o; v[q][j] = o; ss += (o.x * o.x + o.y * o.y) + (o.z * o.z + o.w * o.w); }
            if (l == 0 && !dry) { ss = wave_sum(ss);
                u32x2* o = (u32x2*)(XB + (size_t)t * 1024) + F.lane;
#pragma unroll
                for (int j = 0; j < 4; ++j) { u32x2 wv; wv.x = pk2(v[q][j].x, v[q][j].y); wv.y = pk2(v[q][j].z, v[q][j].w); o[64 * j] = wv; }
                if (F.lane == 0) rstd1[t] = 1.0f / sqrtf(ss * (1.0f / 1024.0f) + EPS); } }
    }
}
constexpr int NPHASE = 1 + 9 * DEPTH;
#ifndef MK_LAUNCH_PER_PHASE
#define MK_LAUNCH_PER_PHASE 0
#endif
template <int PH> __device__ __forceinline__ void run_phase(const Frame& F_in, int l_in, int dry = 0) {
    Frame F; int l = l_in; CArgs* ap = (CArgs*)__builtin_amdgcn_kernarg_segment_ptr();
    { int wv = F_in.wave, ln; asm volatile("v_mbcnt_lo_u32_b32 %0, -1, 0\n\tv_mbcnt_hi_u32_b32 %0, -1, %0" : "=v"(ln)); asm volatile("" : "+s"(wv));
      F.wave = wv; F.lane = ln; F.tid = wv * 64 + ln; F.lds = F_in.lds;
      int G = gridDim.x, bx = blockIdx.x; asm volatile("" : "+s"(G), "+s"(bx), "+s"(l), "+s"(ap)); F.G = G; F.vcu = (G % 8 == 0) ? (bx % 8) * (G / 8) + bx / 8 : bx; }
    CArgs& a = *ap;
    LAS unsigned char* ring = F.lds;
    const LAS float* rs_tab = (const LAS float*)(F.lds + MISC_RS);
    const LAS int* moe_tab = (const LAS int*)(F.lds + MISC_TAB);
    bf16* XB = (bf16*)(a.ws + WS_XB);
    if constexpr (PH == 0) { phase_prologue(F, a); }
    if constexpr (PH == 1) {
        pg8::Gemm g{XB, (const bf16*)(a.ws + WS_WIN) + (size_t)l * 1280 * 1024, 1024};
        pg8::StaticOrder S; S.init(NTOK, 1280, F.G, F.G == 256 ? ((F.vcu & 31) * 8 + (F.vcu >> 5)) : F.vcu);
        epi::EpiInProj E{(const float*)(a.ws + WS_SMALL + SM_RSTD1), (bf16*)(a.ws + WS_CQ), (bf16*)(a.ws + WS_CKV), (bf16*)(a.ws + WS_USSM), (bf16*)(a.ws + WS_CONVA), (bf16*)(a.ws + WS_CONVG),
                         (float*)(a.ws + WS_SMALL + SM_SSQQ), (float*)(a.ws + WS_SMALL + SM_SSQKV), (float*)(a.ws + WS_SMALL + SM_SSQPE)};
        pg8::gemm_phase<epi::EpiInProj, pg8::StaticOrder, true, -1>(ring, g, S, E, rs_tab, F.tid);
    }
    if constexpr (PH == 2) {
        { pg8::Gemm g{(const bf16*)(a.ws + WS_CQ), (const bf16*)(a.ws + WS_WUQ) + (size_t)l * 1024 * 256, 256};
          pg8::StaticOrder S; S.init(NTOK, 1024, F.G, F.G == 256 ? ((F.vcu & 31) * 8 + (F.vcu >> 5)) : F.vcu);
          epi::EpiUp E{(const float*)(a.ws + WS_SMALL + SM_SSQQ), 1.0f / 256.0f, (bf16*)(a.ws + WS_QRAW)};
          pg8::gemm_phase<epi::EpiUp, pg8::StaticOrder, true, -1>(ring, g, S, E, rs_tab, F.tid); }
    }
    if constexpr (PH == 12) {
        { pg8::Gemm g{(const bf16*)(a.ws + WS_CKV), (const bf16*)(a.ws + WS_WUKV) + (size_t)l * 1024 * 256, 256};
          pg8::StaticOrder S; S.init(NTOK, 1024, F.G, F.G == 256 ? ((F.vcu & 31) * 8 + (F.vcu >> 5)) : F.vcu);
          epi::EpiUp E{(const float*)(a.ws + WS_SMALL + SM_SSQKV), 1.0f / 128.0f, (bf16*)(a.ws + WS_KVRAW)};
          pg8::gemm_phase<epi::EpiUp, pg8::StaticOrder, true, -1>(ring, g, S, E, rs_tab, F.tid); }
    }
    if constexpr (PH == 10) {
        for (int u = F.vcu; u < 128; u += F.G) ssm_unit(F, a, l, u);
    }
    if constexpr (PH == 11) {
        for (int u = F.vcu; u < 256; u += F.G) if (u >= 128) { conv_unit(F, a, l, 2 * (u - 128)); conv_unit(F, a, l, 2 * (u - 128) + 1); }
    }
    if constexpr (PH == 3) {
        { pg8::Gemm g{(const bf16*)(a.ws + WS_Z), (const bf16*)(a.ws + WS_WGLU) + (size_t)l * 256 * 256, 256};
          pg8::StaticOrder S; S.init(NTOK, 256, F.G, F.G == 256 ? ((F.vcu & 31) * 8 + (F.vcu >> 5)) : F.vcu);
          epi::EpiGlu E{(const bf16*)(a.ws + WS_Z), (bf16*)(a.ws + WS_Y)};
          pg8::gemm_phase<epi::EpiGlu, pg8::StaticOrder, false, -1>(ring, g, S, E, rs_tab, F.tid); }
        phase_prep(F, a, l);
    }
    if constexpr (PH == 4) {
        for (int v = F.vcu; v < 256; v += F.G) { const int bh = v >> 2, s = v & 3;
            attn_unit(F, a, bh >> 3, bh & 7, s); attn_unit(F, a, bh >> 3, bh & 7, 7 - s); }
    }
    if constexpr (PH == 5) {
        pg8::Gemm g{(const bf16*)(a.ws + WS_Y), (const bf16*)(a.ws + WS_WOUT) + (size_t)l * 1024 * 1024, 1024};
        pg8::StaticOrder S; S.init(NTOK, 1024, F.G, F.G == 256 ? ((F.vcu & 31) * 8 + (F.vcu >> 5)) : F.vcu);
        pg8::Unit u0; const bool has = S.next(0, u0);
        __syncthreads();
        if (has && F.tid < 256) { const float* q = (const float*)(a.ws + WS_SMALL + SM_SSQO) + (size_t)(u0.pm * 256 + F.tid) * 8; float s = 0.f;
#pragma unroll
            for (int hh = 0; hh < 8; ++hh) s += q[hh];
            ((LAS float*)(F.lds + MISC_RS))[F.tid] = 1.0f / sqrtf(s * (1.0f / 512.0f) + EPS); }
        __syncthreads();
        epi::EpiResidual E{l == 0 ? a.x : (const float*)a.out, a.out};
        pg8::gemm_phase<epi::EpiResidual, pg8::StaticOrder, false, 8>(ring, g, S, E, rs_tab, F.tid);
    }
    if constexpr (PH == 6) phase_router(F, a, l, dry);
    if constexpr (PH == 7) {
        moe_tables(F, a, l);
        pg8::Gemm g{XB, (const bf16*)(a.ws + WS_W13) + (size_t)l * NEXP * 1024 * 1024, 1024};
        MoeSched S{moe_tab, (const int*)(a.ws + WS_TOKLIST), F.G, F.vcu, true};
        epi::EpiMoe1 E{moe_tab, (const float*)(a.ws + WS_SMALL + SM_RSLIST), (bf16*)(a.ws + WS_H)};
        pg8::gemm_phase<epi::EpiMoe1, MoeSched, true, -1>(ring, g, S, E, rs_tab, F.tid);
    }
    if constexpr (PH == 8) {
        moe_tables(F, a, l);
        pg8::Gemm g{(const bf16*)(a.ws + WS_H), (const bf16*)(a.ws + WS_W2) + (size_t)l * NEXP * 1024 * 512, 512};
        MoeSched S{moe_tab, (const int*)(a.ws + WS_TOKLIST), F.G, F.vcu, false};
        epi::EpiMoe2 E{moe_tab, (const float*)(a.ws + WS_GATELIST), (bf16*)(a.ws + WS_YROWS)};
        pg8::gemm_phase<epi::EpiMoe2, MoeSched, true, -1>(ring, g, S, E, rs_tab, F.tid);
    }
    if constexpr (PH == 9) { moe_tables(F, a, l); phase_combine(F, a, l, dry); }
}
__device__ __forceinline__ void make_frame(Frame& F, unsigned char* lds_raw) {
    F.lds = (LAS unsigned char*)lds_raw;
    F.tid = threadIdx.x; F.lane = F.tid & 63; F.wave = __builtin_amdgcn_readfirstlane(F.tid >> 6);
    F.G = gridDim.x; { const int bx = blockIdx.x; F.vcu = (F.G % 8 == 0) ? (bx % 8) * (F.G / 8) + bx / 8 : bx; }
}
template <int PH> __global__ void __launch_bounds__(512, 2) k_phase(Args a, int l) {
    extern __shared__ __attribute__((aligned(16))) unsigned char lds_raw[];
    Frame F; make_frame(F, lds_raw);
    run_phase<PH>(F, l);
}
#if !MK_LAUNCH_PER_PHASE
__global__ void __launch_bounds__(512, 2) fwd_kernel(Args a) {
    extern __shared__ __attribute__((aligned(16))) unsigned char lds_raw[];
    Frame F; make_frame(F, lds_raw);
    unsigned* ctl = (unsigned*)(((CArgs*)__builtin_amdgcn_kernarg_segment_ptr())->ws + WS_CTL);
    if (F.tid < 4) ((LAS unsigned*)(F.lds + MISC_BARW))[F.tid] = 0u;
    __syncthreads();
    (void)xcd_barrier_post(ctl + CW_BAR, (volatile LAS unsigned*)(F.lds + MISC_BARW));
#define GRID_SYNC() do { unsigned* bp_ = (unsigned*)(((CArgs*)__builtin_amdgcn_kernarg_segment_ptr())->ws + WS_CTL) + CW_BAR; asm volatile("" : "+s"(bp_)); \
        XcdBarrier b_; b_.bar = bp_; b_.x = xb_xcc_id(); b_.st = (volatile LAS unsigned*)(F.lds + MISC_BARW); xcd_barrier(b_); } while (0)
#ifndef REP_MASK
#define REP_MASK 0
#endif
#if REP_MASK
#define RUN(PH, l) do { int nrep_ = ((REP_MASK >> PH) & 1) ? 2 : 1; asm volatile("" : "+s"(nrep_)); for (int rep_ = 0; rep_ < nrep_; ++rep_) { if (rep_) GRID_SYNC(); run_phase<PH>(F, l, rep_); } } while (0)
#else
#define RUN(PH, l) run_phase<PH>(F, l)
#endif
    RUN(0, 0); GRID_SYNC();
    for (int l = 0; l < DEPTH; ++l) {
        RUN(1, l); GRID_SYNC();
        RUN(2, l); RUN(12, l); RUN(10, l); RUN(11, l); GRID_SYNC();
        RUN(3, l); GRID_SYNC();
        RUN(4, l); GRID_SYNC();
        RUN(5, l); GRID_SYNC();
        RUN(6, l); GRID_SYNC();
        RUN(7, l); GRID_SYNC();
        RUN(8, l); GRID_SYNC();
        RUN(9, l); if (l + 1 < DEPTH) GRID_SYNC();
#ifdef EXTRA_SYNCS
        for (int xs_ = 0; xs_ < EXTRA_SYNCS; ++xs_) GRID_SYNC();
#endif
    }
}
#endif

extern "C" void kernel_launch(void* const* d_in, const int* in_sizes, int n_in, void* d_out, int out_size, void* d_ws, size_t ws_size, hipStream_t stream) {
    static int grid = 0;
    if (grid == 0) {
        if (n_in != 33 || ws_size < WS_END) { fprintf(stderr, "kernel_launch: unexpected inputs (n_in %d, ws %zu)\n", n_in, ws_size); grid = -1; return; }
#if !MK_LAUNCH_PER_PHASE
        if (hipFuncSetAttribute((const void*)fwd_kernel, hipFuncAttributeMaxDynamicSharedMemorySize, LDS_BYTES) != hipSuccess) { grid = -1; return; }
#else
#define SA(K) if (hipFuncSetAttribute((const void*)K, hipFuncAttributeMaxDynamicSharedMemorySize, LDS_BYTES) != hipSuccess) { fprintf(stderr, "kernel_launch: hipFuncSetAttribute failed\n"); grid = -1; return; }
        SA(k_phase<0>) SA(k_phase<1>) SA(k_phase<2>) SA(k_phase<3>) SA(k_phase<4>) SA(k_phase<5>) SA(k_phase<6>) SA(k_phase<7>) SA(k_phase<8>) SA(k_phase<9>) SA(k_phase<10>) SA(k_phase<11>) SA(k_phase<12>)
#undef SA
#endif
        int per_cu = 0;
#if !MK_LAUNCH_PER_PHASE
        if (hipOccupancyMaxActiveBlocksPerMultiprocessor(&per_cu, (const void*)fwd_kernel, 512, LDS_BYTES) != hipSuccess || per_cu < 1) fprintf(stderr, "kernel_launch: occupancy query reports %d\n", per_cu);
        (void)hipGetLastError();
#endif
        (void)per_cu;
        grid = 256;
    }
    if (grid < 0) return;
    (void)hipMemsetAsync((char*)d_ws + WS_CTL, 0, CTL_ZERO_BYTES, stream);
    Args a{};

    a.x = (const float*)d_in[0]; a.pos = (const int*)d_in[1]; a.mix_norm = (const float*)d_in[2]; a.w_in = (const float*)d_in[3]; a.q_a_norm = (const float*)d_in[4];
    a.w_uq = (const float*)d_in[5]; a.kv_a_norm = (const float*)d_in[6]; a.w_ukv = (const float*)d_in[7]; a.q_norm = (const float*)d_in[8]; a.k_norm = (const float*)d_in[9];
    a.lam_re = (const float*)d_in[10]; a.lam_im = (const float*)d_in[11]; a.b_re = (const float*)d_in[12]; a.b_im = (const float*)d_in[13]; a.c_re = (const float*)d_in[14];
    a.c_im = (const float*)d_in[15]; a.ssm_d = (const float*)d_in[16]; a.log_dt = (const float*)d_in[17]; a.w_glu = (const float*)d_in[18]; a.dw_w = (const float*)d_in[19];
    a.dw_b = (const float*)d_in[20]; a.ln_w = (const float*)d_in[21]; a.ln_b = (const float*)d_in[22]; a.out_norm = (const float*)d_in[23]; a.w_out = (const float*)d_in[24];
    a.ffn_norm = (const float*)d_in[25]; a.w_grp = (const float*)d_in[26]; a.b_grp = (const float*)d_in[27]; a.w_exp = (const float*)d_in[28]; a.b_exp = (const float*)d_in[29];
    a.w1 = (const float*)d_in[30]; a.w3 = (const float*)d_in[31]; a.w2 = (const float*)d_in[32];

    a.out = (float*)d_out; a.ws = (unsigned char*)d_ws;
#if MK_LAUNCH_PER_PHASE
#define LP(PH, l) hipLaunchKernelGGL(k_phase<PH>, dim3(grid), dim3(512), LDS_BYTES, stream, a, l)
    LP(0, 0);
    for (int l = 0; l < DEPTH; ++l) { LP(1, l); LP(2, l); LP(12, l); LP(10, l); LP(11, l); LP(3, l); LP(4, l); LP(5, l); LP(6, l); LP(7, l); LP(8, l); LP(9, l); }
#undef LP
#else
    hipLaunchKernelGGL(fwd_kernel, dim3(grid), dim3(512), LDS_BYTES, stream, a);
#endif
    const hipError_t le = hipPeekAtLastError();
    if (le != hipSuccess) fprintf(stderr, "kernel_launch: launch failed: %s\n", hipGetErrorName(le));
}
```
